# Optimizing an MI355X kernel written in HIP

```python
import math
import jax, jax.numpy as jnp
from jax import lax
import numpy as np

D_MODEL = 2048
BATCH = 2
SEQ = 16384
DEPTH = 1

CHUNK = 64
N_META = 16
EPS = 1e-6
D_SC = D_MODEL
SC_KERNEL = 3
MB_EXPAND = 2
D_INNER = MB_EXPAND * D_MODEL
MB_HEADDIM = 64
MB_HEADS = D_INNER // MB_HEADDIM
MB_GROUPS = 8
MB_STATE = 128
MB_CONV = 4
D_BC = MB_GROUPS * MB_STATE
D_XBC = D_INNER + 2 * D_BC
N_BRANCH = 2
D_FF = 5504
FFN_KERNEL = 3
IN_SIZES = (D_SC, D_SC, D_SC, D_INNER, D_XBC, MB_HEADS, N_BRANCH * D_MODEL)
D_IN_PROJ = 3 * D_SC + D_INNER + D_XBC + MB_HEADS + N_BRANCH * D_MODEL

kernel_name = "hybrid_shortconv_ssd_gated_block"


def rmsnorm(x, g):
    x32 = x.astype(jnp.float32)
    y = x32 * lax.rsqrt(jnp.mean(x32 * x32, axis=-1, keepdims=True) + EPS)
    return (y * g.astype(jnp.float32)).astype(x.dtype)


def causal_dwconv(x, w, b=None):
    K = w.shape[0]
    L = x.shape[1]
    xp = jnp.pad(x, ((0, 0), (K - 1, 0), (0, 0)))
    y = xp[:, K - 1:K - 1 + L] * w[K - 1]
    for k in range(K - 1):
        y = y + xp[:, k:k + L] * w[k]
    if b is not None:
        y = y + b
    return y


def split_cols(a, sizes):
    idx, run = [], 0
    for s in sizes[:-1]:
        run += s
        idx.append(run)
    return jnp.split(a, idx, axis=-1)


def ssd_chunked(xs, dt, A, Bm, Cm):
    b, T, H, P = xs.shape
    G, N = Bm.shape[2], Bm.shape[3]
    R = H // G
    nc = T // CHUNK
    f32 = jnp.float32
    x = xs.astype(f32).reshape(b, nc, CHUNK, G, R, P)
    dtc = dt.astype(f32).reshape(b, nc, CHUNK, G, R)
    Bc = Bm.astype(f32).reshape(b, nc, CHUNK, G, N)
    Cc = Cm.astype(f32).reshape(b, nc, CHUNK, G, N)
    acum = jnp.cumsum(dtc * A.astype(f32).reshape(G, R), axis=2)
    xdt = x * dtc[..., None]
    acum_t = jnp.moveaxis(acum, 2, -1)
    seg = acum_t[..., :, None] - acum_t[..., None, :]
    causal = jnp.tril(jnp.ones((CHUNK, CHUNK), dtype=bool))
    decay = jnp.exp(jnp.where(causal, seg, -jnp.inf))
    cb = jnp.einsum('bclgn,bcsgn->bcgls', Cc, Bc)
    y_diag = jnp.einsum('bcgrls,bcsgrp->bclgrp', decay * cb[:, :, :, None], xdt)
    a_last = acum[:, :, -1:]
    state_in = xdt * jnp.exp(a_last - acum)[..., None]
    chunk_decay = jnp.exp(a_last[:, :, 0])
    out_decay = jnp.exp(acum)

    def step(state, inp):
        Bk, Ck, sik, cdk, odk = inp
        y_off = jnp.einsum('blgn,bgrpn->blgrp', Ck, state) * odk[..., None]
        state = state * cdk[..., None, None] + jnp.einsum('blgn,blgrp->bgrpn', Bk, sik)
        return state, y_off

    to_c = lambda t: jnp.moveaxis(t, 1, 0)
    state0 = jnp.zeros((b, G, R, P, N), f32)
    _, y_off = lax.scan(step, state0, (to_c(Bc), to_c(Cc), to_c(state_in), to_c(chunk_decay), to_c(out_decay)))
    y = y_diag + jnp.moveaxis(y_off, 0, 1)
    return y.reshape(b, T, H, P).astype(xs.dtype)


def hybrid_layer(h, norm1_g, w_in, b_gate, sc_conv_w, mb_conv_w, mb_conv_b, dt_bias, a_log,
                 d_skip, mb_norm_g, w_a, w_m, w_o, norm2_g, w_up, ffn_conv_w, ffn_conv_b, w_down):
    bsz, L, _ = h.shape
    xn = rmsnorm(h, norm1_g)
    proj = xn @ w_in
    sc_b, sc_c, sc_h, z, xbc, dt_raw, gate_raw = split_cols(proj, IN_SIZES)

    y_a = sc_b * causal_dwconv(sc_c * sc_h, sc_conv_w)

    xbc = jax.nn.silu(causal_dwconv(xbc, mb_conv_w, mb_conv_b))
    xs, Bm, Cm = jnp.split(xbc, [D_INNER, D_INNER + D_BC], axis=-1)
    xs = xs.reshape(bsz, L, MB_HEADS, MB_HEADDIM)
    dt = jax.nn.softplus(dt_raw.astype(jnp.float32) + dt_bias.astype(jnp.float32))
    A = -jnp.exp(a_log.astype(jnp.float32))
    pad_left = (-L) % CHUNK
    padseq = lambda a: jnp.pad(a, [(0, 0), (pad_left, 0)] + [(0, 0)] * (a.ndim - 2))
    y_ssd = ssd_chunked(padseq(xs), padseq(dt), A,
                        padseq(Bm.reshape(bsz, L, MB_GROUPS, MB_STATE)),
                        padseq(Cm.reshape(bsz, L, MB_GROUPS, MB_STATE)))[:, pad_left:]
    y_m = (y_ssd + xs * d_skip[:, None].astype(xs.dtype)).reshape(bsz, L, D_INNER)
    y_m = y_m * jax.nn.silu(z)
    y_m = rmsnorm(y_m.reshape(bsz, L, MB_GROUPS, D_INNER // MB_GROUPS),
                  mb_norm_g.reshape(MB_GROUPS, D_INNER // MB_GROUPS)).reshape(bsz, L, D_INNER)

    g_a, g_m = jnp.split(jax.nn.sigmoid(gate_raw + b_gate), N_BRANCH, axis=-1)
    mix = g_a * (y_a @ w_a) + g_m * (y_m @ w_m)
    h = h + mix @ w_o

    xn2 = rmsnorm(h, norm2_g)
    u, v = jnp.split(xn2 @ w_up, 2, axis=-1)
    u = causal_dwconv(u, ffn_conv_w, ffn_conv_b)
    h = h + (jax.nn.silu(u) * v) @ w_down
    return h


def setup_inputs(seed: int = 0) -> dict:
    key = jax.random.key(seed)
    ks = jax.random.split(key, 24)
    f32 = jnp.float32
    nrm = lambda k, shape, s: jax.random.normal(k, shape, f32) * s
    x = nrm(ks[0], (BATCH, SEQ, D_MODEL), 1.0)
    meta_tokens = nrm(ks[1], (N_META, D_MODEL), 1.0)
    norm1_g = 1.0 + nrm(ks[2], (DEPTH, D_MODEL), 0.05)
    w_in = nrm(ks[3], (DEPTH, D_MODEL, D_IN_PROJ), D_MODEL ** -0.5)
    b_gate = nrm(ks[4], (DEPTH, N_BRANCH * D_MODEL), 0.1)
    sc_conv_w = nrm(ks[5], (DEPTH, SC_KERNEL, D_SC), SC_KERNEL ** -0.5)
    mb_conv_w = nrm(ks[6], (DEPTH, MB_CONV, D_XBC), MB_CONV ** -0.5)
    mb_conv_b = nrm(ks[7], (DEPTH, D_XBC), 0.01)
    dt0 = jnp.exp(jax.random.uniform(ks[8], (DEPTH, MB_HEADS), f32)
                  * (math.log(0.1) - math.log(0.001)) + math.log(0.001))
    dt_bias = dt0 + jnp.log(-jnp.expm1(-dt0))
    a_log = jnp.log(jax.random.uniform(ks[9], (DEPTH, MB_HEADS), f32, 1.0, 16.0))
    d_skip = 1.0 + nrm(ks[10], (DEPTH, MB_HEADS), 0.1)
    mb_norm_g = 1.0 + nrm(ks[11], (DEPTH, D_INNER), 0.05)
    w_a = nrm(ks[12], (DEPTH, D_SC, D_MODEL), D_SC ** -0.5)
    w_m = nrm(ks[13], (DEPTH, D_INNER, D_MODEL), D_INNER ** -0.5)
    w_o = nrm(ks[14], (DEPTH, D_MODEL, D_MODEL), D_MODEL ** -0.5)
    norm2_g = 1.0 + nrm(ks[15], (DEPTH, D_MODEL), 0.05)
    w_up = nrm(ks[16], (DEPTH, D_MODEL, 2 * D_FF), D_MODEL ** -0.5)
    ffn_conv_w = nrm(ks[17], (DEPTH, FFN_KERNEL, D_FF), FFN_KERNEL ** -0.5)
    ffn_conv_b = nrm(ks[18], (DEPTH, D_FF), 0.01)
    w_down = nrm(ks[19], (DEPTH, D_FF, D_MODEL), D_FF ** -0.5)
    normf_g = 1.0 + nrm(ks[20], (D_MODEL,), 0.05)
    return {"x": x, "meta_tokens": meta_tokens, "norm1_g": norm1_g, "w_in": w_in,
            "b_gate": b_gate, "sc_conv_w": sc_conv_w, "mb_conv_w": mb_conv_w,
            "mb_conv_b": mb_conv_b, "dt_bias": dt_bias, "a_log": a_log, "d_skip": d_skip,
            "mb_norm_g": mb_norm_g, "w_a": w_a, "w_m": w_m, "w_o": w_o, "norm2_g": norm2_g,
            "w_up": w_up, "ffn_conv_w": ffn_conv_w, "ffn_conv_b": ffn_conv_b,
            "w_down": w_down, "normf_g": normf_g}


def reference(x, meta_tokens, norm1_g, w_in, b_gate, sc_conv_w, mb_conv_w, mb_conv_b, dt_bias,
              a_log, d_skip, mb_norm_g, w_a, w_m, w_o, norm2_g, w_up, ffn_conv_w, ffn_conv_b,
              w_down, normf_g):
    bsz = x.shape[0]
    meta = jnp.broadcast_to(meta_tokens[None].astype(x.dtype), (bsz, N_META, D_MODEL))
    h = jnp.concatenate([meta, x], axis=1)
    for i in range(DEPTH):
        h = hybrid_layer(h, norm1_g[i], w_in[i], b_gate[i], sc_conv_w[i], mb_conv_w[i],
                         mb_conv_b[i], dt_bias[i], a_log[i], d_skip[i], mb_norm_g[i], w_a[i],
                         w_m[i], w_o[i], norm2_g[i], w_up[i], ffn_conv_w[i], ffn_conv_b[i],
                         w_down[i])
    return rmsnorm(h[:, N_META:], normf_g)
```

```cpp
#include <hip/hip_runtime.h>
#include <hip/hip_cooperative_groups.h>
#include <cstdio>
#include <cstdint>
namespace cg = cooperative_groups;

namespace pg8 {
#define PG8_LAS __attribute__((address_space(3)))
typedef unsigned short bf16_t;
typedef short bf16x8 __attribute__((ext_vector_type(8)));
typedef float f32x4 __attribute__((ext_vector_type(4)));
typedef unsigned u32x4 __attribute__((ext_vector_type(4)));
constexpr int BM = 256, BK = 64, HALF = 128, HTB = HALF * BK * 2  , STAGE_BYTES = 8 * HTB, NXCD = 8, WGM = 8;

__host__ __device__ __forceinline__ int lds_byte(int r, int c) { const int st = (r >> 4) * 2 + (c >> 5), rr = r & 15, cc = c & 31, ob = rr * 64 + cc * 2; return st * 1024 + (ob ^ (((ob >> 9) & 1) << 5)); }
__host__ __device__ __forceinline__ void stage_rc(int b, int& R, int& C) { const int st = b / 1024, sb = b % 1024, swz = sb ^ (((sb >> 9) & 1) << 5); R = (st >> 1) * 16 + swz / 64; C = (st & 1) * 32 + (swz % 64) / 2; }
__host__ __device__ __forceinline__ int perm32(int rho) { const int n = rho >> 4, i = rho & 15; return 8 * (i >> 2) + 4 * n + (i & 3); }

struct Unit { int pm, pn; };
struct Gemm { const bf16_t* A; const bf16_t* Bt; int M, N, K; };

struct StaticOrder {
    int nM, nN, nwg, G, c;
    __host__ __device__ void init(int M, int N, int G_, int c_) { nM = M / BM; nN = N / BM; nwg = nM * nN; G = G_; c = c_; }
    __host__ __device__ bool next(int i, Unit& u) const {
        const long L = (long)i * G + c; if (L >= nwg) return false;
        int wgid = (int)L; { const int q = nwg / NXCD, r = nwg % NXCD, xcd = wgid % NXCD, off = wgid / NXCD; wgid = (xcd < r ? xcd * (q + 1) : r * (q + 1) + (xcd - r) * q) + off; }
        const int nig = WGM * nN, gid = wgid / nig, fm = gid * WGM, gsz = (nM - fm) < WGM ? (nM - fm) : WGM;
        u.pm = fm + ((wgid % nig) % gsz); u.pn = (wgid % nig) / gsz; return true;
    }
    __device__ __forceinline__ void a_ready(const Unit&) const {}
    __device__ __forceinline__ void done(const Unit&) const {}
};
__device__ __forceinline__ unsigned cvt_pk_bf16(float lo, float hi) { unsigned r; asm volatile("v_cvt_pk_bf16_f32 %0, %1, %2" : "=v"(r) : "v"(lo), "v"(hi)); return r; }
template <class Epi, class Sched, bool ALIGN_EPI = false, bool SP2 = false>
__device__ __forceinline__ void gemm_phase(PG8_LAS unsigned char* lds, const Gemm g, const Sched& S, const Epi& E) {
    int tid_l = threadIdx.x; asm volatile("" : "+v"(tid_l)); const int tid = tid_l, wid = __builtin_amdgcn_readfirstlane(tid >> 6), lane = tid & 63, wr = wid >> 2, wc = wid & 3, fr = lane & 15, fq = lane >> 4;
    const int K = g.K, nt = K / BK;
    unsigned voffA[2], voffB[2];
#pragma unroll
    for (int i = 0; i < 2; ++i) { int R, C; stage_rc(tid * 16 + i * 8192, R, C); const int Rb = Epi::PERM ? ((R & ~31) + perm32(R & 31)) : R;
        voffA[i] = (unsigned)(R * K + C) * 2u; voffB[i] = (unsigned)(Rb * K + C) * 2u; }
    const size_t kstep = (size_t)(BK * 2);
    const size_t hstep = (size_t)HALF * K * 2;
    const size_t tstep = 2 * hstep;
    const unsigned ldsw = (unsigned)wid * 1024u;
    const int aoff = lds_byte(wr * 64 + fr, fq * 8), boff = lds_byte(wc * 32 + fr, fq * 8);
#define PG8_SA(b, h) (((b) * 2 + (h)) * HTB)
#define PG8_SB(b, h) ((4 + (b) * 2 + (h)) * HTB)
#define PG8_STAGE(bufoff, gbase, voff) do { _Pragma("unroll") for (int _i = 0; _i < 2; ++_i) \
        __builtin_amdgcn_global_load_lds((const unsigned*)((const char*)(gbase) + (voff)[_i]), (PG8_LAS unsigned*)(lds + (bufoff) + ldsw + _i * 8192), 16, 0, 0); } while (0)
#define PG8_LDA(dst, b, h) do { _Pragma("unroll") for (int m = 0; m < 4; ++m) _Pragma("unroll") for (int k = 0; k < 2; ++k) dst[m][k] = *(const PG8_LAS bf16x8*)(lds + PG8_SA(b, h) + aoff + m * 2048 + k * 1024); } while (0)
#define PG8_LDB(dst, b, h) do { _Pragma("unroll") for (int n = 0; n < 2; ++n) _Pragma("unroll") for (int k = 0; k < 2; ++k) dst[n][k] = *(const PG8_LAS bf16x8*)(lds + PG8_SB(b, h) + boff + n * 2048 + k * 1024); } while (0)
#define PG8_MMA(ai, bj, At, Bt) do { __builtin_amdgcn_s_setprio(1); _Pragma("unroll") for (int m = 0; m < 4; ++m) _Pragma("unroll") for (int n = 0; n < 2; ++n) _Pragma("unroll") for (int k = 0; k < 2; ++k) \
        acc[ai][bj][m][n] = __builtin_amdgcn_mfma_f32_16x16x32_bf16(Bt[n][k], At[m][k], acc[ai][bj][m][n], 0, 0, 0); __builtin_amdgcn_s_setprio(0); } while (0)
#define PG8_WAIT_V(n) asm volatile("s_waitcnt vmcnt(" #n ")" ::: "memory")
#define PG8_WAIT_L(n) asm volatile("s_waitcnt lgkmcnt(" #n ")" ::: "memory")
#define PG8_BAR __builtin_amdgcn_s_barrier()
#define PG8_SCHED __builtin_amdgcn_sched_barrier(0)
    Unit cur, nxt; int ui = 0;
    if (!S.next(0, cur)) return;
    f32x4 acc[2][2][4][2];
#pragma unroll
    for (int a = 0; a < 2; ++a)
#pragma unroll
        for (int b = 0; b < 2; ++b)
#pragma unroll
            for (int m = 0; m < 4; ++m)
#pragma unroll
                for (int n = 0; n < 2; ++n) acc[a][b][m][n] = (f32x4){0.f, 0.f, 0.f, 0.f};
    bf16x8 At[4][2], B0[2][2], B1[2][2];
    const char* cA = (const char*)g.A + (size_t)cur.pm * tstep; const char* cB = (const char*)g.Bt + (size_t)cur.pn * tstep;
    S.a_ready(cur);
    if constexpr (SP2) {
        PG8_STAGE(PG8_SB(0, 0), cB, voffB); PG8_STAGE(PG8_SB(0, 1), cB + hstep, voffB); PG8_STAGE(PG8_SA(0, 0), cA, voffA); PG8_STAGE(PG8_SA(0, 1), cA + hstep, voffA);
        if (wr == 1) PG8_BAR;
        PG8_WAIT_V(2); PG8_BAR;
        PG8_STAGE(PG8_SB(1, 0), cB + kstep, voffB); PG8_STAGE(PG8_SA(1, 0), cA + kstep, voffA); PG8_STAGE(PG8_SB(1, 1), cB + hstep + kstep, voffB);
        PG8_WAIT_V(6); PG8_BAR;
    } else {
        PG8_STAGE(PG8_SB(0, 0), cB, voffB); PG8_STAGE(PG8_SA(0, 0), cA, voffA); PG8_STAGE(PG8_SB(0, 1), cB + hstep, voffB); PG8_STAGE(PG8_SA(0, 1), cA + hstep, voffA);
        if (wr == 1) PG8_BAR;
        PG8_WAIT_V(4); PG8_BAR;
        PG8_STAGE(PG8_SB(1, 0), cB + kstep, voffB); PG8_STAGE(PG8_SA(1, 0), cA + kstep, voffA); PG8_STAGE(PG8_SB(1, 1), cB + hstep + kstep, voffB);
        PG8_WAIT_V(6); PG8_BAR;
    }
    for (;;) {
        const bool has_next = S.next(ui + 1, nxt);
        const char* nA = has_next ? (const char*)g.A + (size_t)nxt.pm * tstep : cA; const char* nB = has_next ? (const char*)g.Bt + (size_t)nxt.pn * tstep : cB;
        for (int t = 0; t < nt; t += 2) {
            const bool last = (t == nt - 2);
            const char* a1 = cA + (size_t)(t + 1) * kstep;
            const char* a2 = last ? nA : cA + (size_t)(t + 2) * kstep; const char* b2 = last ? nB : cB + (size_t)(t + 2) * kstep;
            const char* a3 = a2 + kstep; const char* b3 = b2 + kstep;
            if (last && has_next) S.a_ready(nxt);
            if constexpr (SP2) {
            PG8_LDB(B0, 0, 0); PG8_LDB(B1, 0, 1); PG8_SCHED; PG8_LDA(At, 0, 0); PG8_STAGE(PG8_SA(1, 1), a1 + hstep, voffA);
            PG8_WAIT_V(8); PG8_WAIT_L(0); PG8_BAR; PG8_MMA(0, 0, At, B0); PG8_MMA(0, 1, At, B1); PG8_BAR; PG8_SCHED;
            PG8_LDA(At, 0, 1); PG8_STAGE(PG8_SB(0, 0), b2, voffB); PG8_STAGE(PG8_SB(0, 1), b2 + hstep, voffB); PG8_STAGE(PG8_SA(0, 0), a2, voffA);
            PG8_WAIT_V(8); PG8_WAIT_L(0); PG8_BAR; PG8_MMA(1, 0, At, B0); PG8_MMA(1, 1, At, B1); PG8_BAR; PG8_SCHED;
            PG8_LDB(B0, 1, 0); PG8_LDB(B1, 1, 1); PG8_SCHED; PG8_LDA(At, 1, 0); PG8_STAGE(PG8_SA(0, 1), a2 + hstep, voffA);
            PG8_WAIT_V(8); PG8_WAIT_L(0); PG8_BAR; PG8_MMA(0, 0, At, B0); PG8_MMA(0, 1, At, B1); PG8_BAR; PG8_SCHED;
            PG8_LDA(At, 1, 1); PG8_STAGE(PG8_SB(1, 0), b3, voffB); PG8_STAGE(PG8_SB(1, 1), b3 + hstep, voffB); PG8_STAGE(PG8_SA(1, 0), a3, voffA);
            PG8_WAIT_V(8); PG8_WAIT_L(0); PG8_BAR; PG8_MMA(1, 0, At, B0); PG8_MMA(1, 1, At, B1); PG8_BAR; PG8_SCHED;
            } else {
            PG8_LDB(B0, 0, 0); PG8_SCHED; PG8_LDA(At, 0, 0); PG8_STAGE(PG8_SA(1, 1), a1 + hstep, voffA);
            PG8_WAIT_L(8); PG8_BAR; PG8_WAIT_L(0); PG8_MMA(0, 0, At, B0); PG8_BAR; PG8_SCHED;
            PG8_LDB(B1, 0, 1); PG8_STAGE(PG8_SB(0, 0), b2, voffB);
            PG8_BAR; PG8_WAIT_L(0); PG8_MMA(0, 1, At, B1); PG8_BAR;
            PG8_LDA(At, 0, 1); PG8_STAGE(PG8_SA(0, 0), a2, voffA);
            PG8_BAR; PG8_WAIT_L(0); PG8_MMA(1, 0, At, B0); PG8_BAR; PG8_SCHED;
            PG8_STAGE(PG8_SB(0, 1), b2 + hstep, voffB);
            PG8_WAIT_V(6); PG8_BAR; PG8_MMA(1, 1, At, B1); PG8_BAR;
            PG8_LDB(B0, 1, 0); PG8_SCHED; PG8_LDA(At, 1, 0); PG8_STAGE(PG8_SA(0, 1), a2 + hstep, voffA);
            PG8_WAIT_L(8); PG8_BAR; PG8_WAIT_L(0); PG8_MMA(0, 0, At, B0); PG8_BAR; PG8_SCHED;
            PG8_LDB(B1, 1, 1); PG8_STAGE(PG8_SB(1, 0), b3, voffB);
            PG8_BAR; PG8_WAIT_L(0); PG8_MMA(0, 1, At, B1); PG8_BAR;
            PG8_LDA(At, 1, 1); PG8_STAGE(PG8_SA(1, 0), a3, voffA);
            PG8_BAR; PG8_WAIT_L(0); PG8_MMA(1, 0, At, B0); PG8_BAR; PG8_SCHED;
            PG8_STAGE(PG8_SB(1, 1), b3 + hstep, voffB);
            PG8_WAIT_V(6); PG8_BAR; PG8_MMA(1, 1, At, B1); PG8_BAR;
            }
        }
        if constexpr (ALIGN_EPI) { if (wr == 0) PG8_BAR; }
        if constexpr (!Epi::AFTER_DRAIN) { E(acc, cur, wr, wc, fr, fq); S.done(cur); }
        if (!has_next) break;
#pragma unroll
        for (int a = 0; a < 2; ++a)
#pragma unroll
            for (int b = 0; b < 2; ++b)
#pragma unroll
                for (int m = 0; m < 4; ++m)
#pragma unroll
                    for (int n = 0; n < 2; ++n) acc[a][b][m][n] = (f32x4){0.f, 0.f, 0.f, 0.f};
        cur = nxt; cA = nA; cB = nB; ++ui;
        if constexpr (ALIGN_EPI) { if (wr == 1) PG8_BAR; }
    }
    PG8_WAIT_V(0);
    if constexpr (!ALIGN_EPI) { if (wr == 0) PG8_BAR; }
    PG8_BAR;
    if constexpr (Epi::AFTER_DRAIN) { E.fused(acc, cur, wr, wc, fr, fq, lds, wid, lane); S.done(cur); }
#undef PG8_SA
#undef PG8_SB
#undef PG8_STAGE
#undef PG8_LDA
#undef PG8_LDB
#undef PG8_MMA
#undef PG8_WAIT_V
#undef PG8_WAIT_L
#undef PG8_BAR
#undef PG8_SCHED
}
}

#define GAS __attribute__((address_space(1)))
#define LAS __attribute__((address_space(3)))
typedef unsigned short bf16;
typedef unsigned v4u __attribute__((ext_vector_type(4)));
typedef unsigned v2u __attribute__((ext_vector_type(2)));
typedef float f32x4 __attribute__((ext_vector_type(4)));
typedef short bf16x8 __attribute__((ext_vector_type(8)));
using pg8::cvt_pk_bf16;

constexpr int DM = 2048, NBATCH = 2, SEQ = 16384, NMETA = 16;
constexpr int NSEG = 4, TSEG = SEQ / NSEG, RS = NBATCH * TSEG, RSB = RS + 256;
constexpr int DINNER = 4096, NHEAD = 64, NGRP = 8, NST = 128, DXBC = 6144, DFF = 5504, NUP = 2 * DFF;
constexpr int NPROJ = 20480, NWIN = 20544;
constexpr int OFF_SCB = 0, OFF_SCC = 2048, OFF_SCH = 4096, OFF_Z = 6144, OFF_XBC = 10240, OFF_GATE = 16384, OFF_DT = 20480;
constexpr float EPS = 1e-6f;
constexpr int NTHREADS = 512, LDS_STAGE = 131072, LDS_XCH = LDS_STAGE + 256, LDS_BYTES = LDS_XCH + 4096;

constexpr size_t al256(size_t x) { return (x + 255) & ~(size_t)255; }
constexpr size_t WS_WIN = 0;
constexpr size_t WS_WA = WS_WIN + (size_t)NWIN * DM * 2;
constexpr size_t WS_WM = WS_WA + (size_t)DM * DM * 2;
constexpr size_t WS_WO = WS_WM + (size_t)DM * DINNER * 2;
constexpr size_t WS_WUP = WS_WO + (size_t)DM * DM * 2;
constexpr size_t WS_WDN = WS_WUP + (size_t)NUP * DM * 2;
constexpr size_t WS_XB = WS_WDN + (size_t)DM * DFF * 2;
constexpr size_t WS_RSTD1 = WS_XB + (size_t)NSEG * RSB * DM * 2;
constexpr size_t WS_PROJ = al256(WS_RSTD1 + (size_t)NSEG * RSB * 4);
constexpr size_t WS_UP = WS_PROJ;
constexpr size_t WS_H1 = WS_UP + (size_t)RSB * NUP * 2;
constexpr size_t WS_H1B = WS_H1 + (size_t)RSB * DM * 4;
constexpr size_t WS_YA = WS_PROJ + (size_t)RSB * NPROJ * 2;
constexpr size_t WS_XCONV = WS_YA + (size_t)RSB * DM * 2;
constexpr size_t WS_ACT = WS_XCONV;
constexpr size_t WS_DT = WS_XCONV + (size_t)RSB * DXBC * 2;
constexpr size_t WS_YPRE = WS_DT + (size_t)RSB * 64 * 4;
constexpr size_t WS_TA = WS_YPRE + (size_t)RSB * DINNER * 2;
constexpr size_t WS_MIX = WS_TA + (size_t)RSB * DM * 4;
constexpr size_t WS_SSQ2 = WS_MIX + (size_t)RSB * DM * 2;
constexpr size_t WS_SSQ3 = WS_SSQ2 + (size_t)RSB * 32 * 4;
constexpr size_t WS_STATE = WS_SSQ3 + (size_t)NSEG * RS * 32 * 4;
constexpr size_t WS_CPROJ = WS_STATE + (size_t)2 * 2 * 64 * 64 * 128 * 4;
constexpr size_t WS_CUP = al256(WS_CPROJ + (size_t)2 * 2 * 3 * NPROJ * 2);
constexpr size_t WS_SSQM = al256(WS_CUP + (size_t)2 * 2 * 2 * NUP * 2);
constexpr size_t WS_ACUM = WS_SSQM + 16 * 128 * 4;
constexpr size_t WS_EU = WS_ACUM + (size_t)RSB * 64 * 4;
constexpr size_t WS_EV = WS_EU + (size_t)2 * 32 * 4 * DFF * 4;
constexpr size_t WS_UMETA = WS_EV + (size_t)32 * 2 * DFF * 4;
constexpr size_t WS_BAR = al256(WS_UMETA + (size_t)2 * DFF * 4);
constexpr size_t WS_END = WS_BAR + 16384;
static_assert(WS_H1B + (size_t)RSB * DM * 2 <= WS_YA, "up|h1|h1b overlay fits in proj");
static_assert(WS_END <= (size_t)1073741824, "workspace map must fit 1 GiB");

struct Params {
    const float *x, *meta, *norm1_g, *w_in, *b_gate, *sc_conv_w, *mb_conv_w, *mb_conv_b, *dt_bias, *a_log, *d_skip, *mb_norm_g, *w_a, *w_m, *w_o, *norm2_g, *w_up, *ffn_conv_w, *ffn_conv_b, *w_down, *normf_g;
    float* out; unsigned char* ws;
};

#define LDS_WAIT() asm volatile("s_waitcnt lgkmcnt(0)" ::: "memory")
typedef GAS unsigned char* gws_t;
__device__ __forceinline__ gws_t launder_s(const void* p0) { unsigned char* p = (unsigned char*)p0; asm volatile("" : "+s"(p)); return (gws_t)p; }
__device__ __forceinline__ int launder_v(int v) { asm volatile("" : "+v"(v)); return v; }
__device__ __forceinline__ int grid_x() { int g = (int)gridDim.x; asm volatile("" : "+s"(g)); return g; }
__device__ __forceinline__ unsigned f2bf(float f) { return (unsigned)__builtin_bit_cast(unsigned short, (__bf16)f); }
__device__ __forceinline__ unsigned pk2(float lo, float hi) { return cvt_pk_bf16(lo, hi); }
__device__ __forceinline__ bf16 f2bfh(float f) { return (bf16)(cvt_pk_bf16(f, f) & 0xffffu); }
__device__ __forceinline__ float bf2f(unsigned short b) { return __builtin_bit_cast(float, (unsigned)b << 16); }
__device__ __forceinline__ float bflo(unsigned w) { return __builtin_bit_cast(float, w << 16); }
__device__ __forceinline__ float bfhi(unsigned w) { return __builtin_bit_cast(float, w & 0xffff0000u); }
__device__ __forceinline__ void unpack8(const v4u v, float (&f)[8]) { f[0] = bflo(v.x); f[1] = bfhi(v.x); f[2] = bflo(v.y); f[3] = bfhi(v.y); f[4] = bflo(v.z); f[5] = bfhi(v.z); f[6] = bflo(v.w); f[7] = bfhi(v.w); }
__device__ __forceinline__ v4u pack8(const float (&f)[8]) { v4u o; o.x = cvt_pk_bf16(f[0], f[1]); o.y = cvt_pk_bf16(f[2], f[3]); o.z = cvt_pk_bf16(f[4], f[5]); o.w = cvt_pk_bf16(f[6], f[7]); return o; }
__device__ __forceinline__ float sigmoidf_(float x) { return __builtin_amdgcn_rcpf(1.f + __expf(-x)); }
__device__ __forceinline__ float siluf_(float x) { return x * __builtin_amdgcn_rcpf(1.f + __expf(-x)); }
__device__ __forceinline__ float wave_sum(float v) {
#pragma unroll
    for (int o = 1; o < 64; o <<= 1) v += __shfl_xor(v, o);
    return v;
}

struct Epi1 {
    static constexpr bool PERM = true, AFTER_DRAIN = false;
    GAS bf16* O; const GAS float* rstd;
    __device__ __forceinline__ void operator()(const f32x4 (&acc)[2][2][4][2], const pg8::Unit& u, int wr, int wc, int fr, int fq) const {
        const int row0 = u.pm * 256 + wr * 64 + fr, col0 = u.pn * 256 + wc * 32 + 8 * fq;
        float rs[8];
#pragma unroll
        for (int i = 0; i < 8; ++i) rs[i] = rstd[row0 + (i >> 2) * 128 + (i & 3) * 16];
#pragma unroll
        for (int ai = 0; ai < 2; ++ai)
#pragma unroll
            for (int m = 0; m < 4; ++m) { const int row = row0 + ai * 128 + m * 16; const float r = rs[ai * 4 + m]; GAS bf16* rowp = O + (size_t)row * NPROJ + col0;
#pragma unroll
                for (int bj = 0; bj < 2; ++bj) { const f32x4 v0 = acc[ai][bj][m][0] * r, v1 = acc[ai][bj][m][1] * r; v4u w;
                    w.x = cvt_pk_bf16(v0[0], v0[1]); w.y = cvt_pk_bf16(v0[2], v0[3]); w.z = cvt_pk_bf16(v1[0], v1[1]); w.w = cvt_pk_bf16(v1[2], v1[3]);
                    *(GAS v4u*)(rowp + bj * 128) = w; } }
    }
};
template <int WHICH> struct EpiGate {
    static constexpr bool PERM = true, AFTER_DRAIN = false;
    const GAS bf16* proj; const float* bgate; GAS bf16* ta; GAS bf16* mix;
    __device__ __forceinline__ void operator()(const f32x4 (&acc)[2][2][4][2], const pg8::Unit& u, int wr, int wc, int fr, int fq) const {
        const int row0 = u.pm * 256 + wr * 64 + fr, col0 = u.pn * 256 + wc * 32 + 8 * fq;
#pragma unroll
        for (int bj = 0; bj < 2; ++bj) { const int col = col0 + bj * 128;
            const f32x4 b0 = *(const GAS f32x4*)(bgate + WHICH * DM + col), b1 = *(const GAS f32x4*)(bgate + WHICH * DM + col + 4);
#pragma unroll
            for (int aim = 0; aim < 4; ++aim) { const int ai = aim >> 1, mb = (aim & 1) * 2;
                v4u gv[4], tv[4];
#pragma unroll
                for (int m = mb; m < mb + 2; ++m) { const int row = row0 + ai * 128 + m * 16;
                    gv[m] = __builtin_nontemporal_load((const GAS v4u*)(proj + (size_t)row * NPROJ + OFF_GATE + WHICH * DM + col));
                    if (WHICH == 1) tv[m] = *(const GAS v4u*)(ta + (size_t)row * DM + col); }
#pragma unroll
                for (int m = mb; m < mb + 2; ++m) { const int row = row0 + ai * 128 + m * 16; float g[8]; unpack8(gv[m], g);
                    const f32x4 a0 = acc[ai][bj][m][0], a1 = acc[ai][bj][m][1]; float r[8];
#pragma unroll
                    for (int e = 0; e < 4; ++e) { r[e] = sigmoidf_(g[e] + b0[e]) * a0[e]; r[4 + e] = sigmoidf_(g[4 + e] + b1[e]) * a1[e]; }
                    if (WHICH == 0) *(GAS v4u*)(ta + (size_t)row * DM + col) = pack8(r);
                    else { float tf[8]; unpack8(tv[m], tf);
#pragma unroll
                        for (int e = 0; e < 8; ++e) r[e] += tf[e];
                        *(GAS v4u*)(mix + (size_t)row * DM + col) = pack8(r); } }
            }
        }
    }
};
struct Epi4 {
    static constexpr bool PERM = true, AFTER_DRAIN = false;
    const float* x; const float* meta; GAS bf16* h1b; GAS float* ssq; int seg;
    __device__ __forceinline__ void operator()(const f32x4 (&acc)[2][2][4][2], const pg8::Unit& u, int wr, int wc, int fr, int fq) const {
        const int row0 = u.pm * 256 + wr * 64 + fr, col0 = u.pn * 256 + wc * 32 + 8 * fq;
#pragma unroll
        for (int aim = 0; aim < 4; ++aim) { const int ai = aim >> 1, mb = (aim & 1) * 2;
            f32x4 hx[4][2][2];
#pragma unroll
            for (int m = mb; m < mb + 2; ++m) { const int row = row0 + ai * 128 + m * 16;
                const GAS float* hp = (const GAS float*)x + ((size_t)(row / TSEG) * SEQ + (size_t)seg * TSEG + (row % TSEG)) * DM + col0;
#pragma unroll
                for (int bj = 0; bj < 2; ++bj) { hx[m][bj][0] = __builtin_nontemporal_load((const GAS f32x4*)(hp + bj * 128)); hx[m][bj][1] = __builtin_nontemporal_load((const GAS f32x4*)(hp + bj * 128 + 4)); } }
#pragma unroll
            for (int m = mb; m < mb + 2; ++m) { const int row = row0 + ai * 128 + m * 16;
                float s = 0.f;
#pragma unroll
                for (int bj = 0; bj < 2; ++bj) { const int col = col0 + bj * 128; const f32x4 v0 = acc[ai][bj][m][0] + hx[m][bj][0], v1 = acc[ai][bj][m][1] + hx[m][bj][1];
                    v4u w; w.x = cvt_pk_bf16(v0[0], v0[1]); w.y = cvt_pk_bf16(v0[2], v0[3]); w.z = cvt_pk_bf16(v1[0], v1[1]); w.w = cvt_pk_bf16(v1[2], v1[3]);
                    *(GAS v4u*)(h1b + (size_t)row * DM + col) = w;
                    s += (v0[0] * v0[0] + v0[1] * v0[1]) + (v0[2] * v0[2] + v0[3] * v0[3]) + (v1[0] * v1[0] + v1[1] * v1[1]) + (v1[2] * v1[2] + v1[3] * v1[3]); }
                s += __shfl_xor(s, 16); s += __shfl_xor(s, 32);
                if (fq == 0) ssq[(size_t)row * 32 + u.pn * 4 + wc] = s; } }
    }
};
template <int N> __device__ __forceinline__ float row_up(float prev, float cur) {
    const int pr = __builtin_amdgcn_update_dpp(0, __builtin_bit_cast(int, prev), 0x120 + N, 0xf, 0xf, false);
    const int r = __builtin_amdgcn_update_dpp(pr, __builtin_bit_cast(int, cur), 0x110 + N, 0xf, 0xf, false);
    return __builtin_bit_cast(float, r);
}
struct Epi5 {
    static constexpr bool PERM = true, AFTER_DRAIN = false;
    GAS bf16* act; const GAS float* ssq; const float* cw; const float* cb; GAS float* eu; GAS float* ev; LAS float* xch;
    __device__ __forceinline__ void operator()(const f32x4 (&acc)[2][2][4][2], const pg8::Unit& u, int wr, int wc, int fr, int fq) const {
        const int row0 = u.pm * 256 + wr * 64 + fr, ch0 = u.pn * 128 + wc * 32 + 8 * fq, lc = wc * 32 + 8 * fq;
        float rs[8];
#pragma unroll
        for (int i = 0; i < 8; ++i) { const int row = row0 + (i >> 2) * 128 + (i & 3) * 16;
            const f32x4 p0 = *(const GAS f32x4*)(ssq + (size_t)row * 32 + fq * 8), p1 = *(const GAS f32x4*)(ssq + (size_t)row * 32 + fq * 8 + 4);
            rs[i] = (p0[0] + p0[1]) + (p0[2] + p0[3]) + (p1[0] + p1[1]) + (p1[2] + p1[3]); }
        float w0[8], w1[8], w2[8], bb[8];
#pragma unroll
        for (int e = 0; e < 8; ++e) { w0[e] = cw[0 * DFF + ch0 + e]; w1[e] = cw[1 * DFF + ch0 + e]; w2[e] = cw[2 * DFF + ch0 + e]; bb[e] = cb[ch0 + e]; }
#pragma unroll
        for (int i = 0; i < 8; ++i) { float s = rs[i]; s += __shfl_xor(s, 16); s += __shfl_xor(s, 32); rs[i] = rsqrtf(s * (1.f / DM) + EPS); }
        float us[2][4][8];
#pragma unroll
        for (int ai = 0; ai < 2; ++ai)
#pragma unroll
            for (int m = 0; m < 4; ++m) { const float r = rs[ai * 4 + m];
#pragma unroll
                for (int e = 0; e < 4; ++e) { us[ai][m][e] = acc[ai][0][m][0][e] * r; us[ai][m][4 + e] = acc[ai][0][m][1][e] * r; } }
        if (fr >= 14) {
#pragma unroll
            for (int ai = 0; ai < 2; ++ai) { LAS float* xp = xch + ((2 * ai + wr) * 2 + (fr - 14)) * 128 + lc;
                *(LAS f32x4*)xp = (f32x4){us[ai][3][0], us[ai][3][1], us[ai][3][2], us[ai][3][3]}; *(LAS f32x4*)(xp + 4) = (f32x4){us[ai][3][4], us[ai][3][5], us[ai][3][6], us[ai][3][7]}; } }
        asm volatile("s_waitcnt lgkmcnt(0)" ::: "memory"); __builtin_amdgcn_s_barrier(); asm volatile("" ::: "memory");
        const int pb = (u.pm & 31);
        GAS float* eup = eu + (size_t)pb * 4 * DFF + ch0; GAS float* evp = ev + (size_t)pb * 2 * DFF + ch0;
#pragma unroll
        for (int ai = 0; ai < 2; ++ai) {
            float prev[8];
            { const int gi = 2 * ai + wr;
              if (gi >= 1 && fr >= 14) { const LAS float* xp = xch + ((gi - 1) * 2 + (fr - 14)) * 128 + lc; const f32x4 a = *(const LAS f32x4*)xp, c = *(const LAS f32x4*)(xp + 4);
#pragma unroll
                  for (int e = 0; e < 4; ++e) { prev[e] = a[e]; prev[4 + e] = c[e]; } }
              else {
#pragma unroll
                  for (int e = 0; e < 8; ++e) prev[e] = 0.f; } }
#pragma unroll
            for (int m = 0; m < 4; ++m) { const int row = row0 + ai * 128 + m * 16; const float r = rs[ai * 4 + m]; float y[8];
#pragma unroll
                for (int e = 0; e < 8; ++e) { const float cur = us[ai][m][e], pv = (m == 0) ? prev[e] : us[ai][m - 1][e];
                    const float um1 = row_up<1>(pv, cur), um2 = row_up<2>(pv, cur);
                    const float vv = ((e < 4) ? acc[ai][1][m][0][e & 3] : acc[ai][1][m][1][e & 3]) * r;
                    y[e] = siluf_(bb[e] + w0[e] * um2 + w1[e] * um1 + w2[e] * cur) * vv; }
                *(GAS v4u*)(act + (size_t)row * DFF + ch0) = pack8(y);
                if (ai == 0 && m == 0 && wr == 0 && fr < 2) {
                    GAS float* p = eup + (size_t)(2 + fr) * DFF; GAS float* q = evp + (size_t)fr * DFF;
#pragma unroll
                    for (int e = 0; e < 8; ++e) { p[e] = us[0][0][e]; q[e] = ((e < 4) ? acc[0][1][0][0][e & 3] : acc[0][1][0][1][e & 3]) * r; } }
                if (ai == 1 && m == 3 && wr == 1 && fr >= 14) {
                    GAS float* p = eup + (size_t)(fr - 14) * DFF;
#pragma unroll
                    for (int e = 0; e < 8; ++e) p[e] = us[1][3][e]; } }
        }
    }
};
struct Epi6 {
    static constexpr bool PERM = true, AFTER_DRAIN = false;
    const GAS bf16* h1; float* out; GAS float* ssq; int seg;
    __device__ __forceinline__ void operator()(const f32x4 (&acc)[2][2][4][2], const pg8::Unit& u, int wr, int wc, int fr, int fq) const {
        const int row0 = u.pm * 256 + wr * 64 + fr, col0 = u.pn * 256 + wc * 32 + 8 * fq;
#pragma unroll
        for (int aim = 0; aim < 4; ++aim) { const int ai = aim >> 1, mb = (aim & 1) * 2;
            v4u hr[4][2];
#pragma unroll
            for (int m = mb; m < mb + 2; ++m) { const GAS bf16* hp = h1 + (size_t)(row0 + ai * 128 + m * 16) * DM + col0;
#pragma unroll
                for (int bj = 0; bj < 2; ++bj) hr[m][bj] = *(const GAS v4u*)(hp + bj * 128); }
#pragma unroll
            for (int m = mb; m < mb + 2; ++m) { const int row = row0 + ai * 128 + m * 16;
                GAS bf16* op = (GAS bf16*)((GAS float*)out + ((size_t)(row / TSEG) * SEQ + (size_t)seg * TSEG + (row % TSEG)) * DM);
                float s = 0.f;
#pragma unroll
                for (int bj = 0; bj < 2; ++bj) { const int col = col0 + bj * 128; float hf[8]; unpack8(hr[m][bj], hf);
                    const f32x4 v0 = acc[ai][bj][m][0] + (f32x4){hf[0], hf[1], hf[2], hf[3]}, v1 = acc[ai][bj][m][1] + (f32x4){hf[4], hf[5], hf[6], hf[7]};
                    { v4u w; w.x = cvt_pk_bf16(v0[0], v0[1]); w.y = cvt_pk_bf16(v0[2], v0[3]); w.z = cvt_pk_bf16(v1[0], v1[1]); w.w = cvt_pk_bf16(v1[2], v1[3]); __builtin_nontemporal_store(w, (GAS v4u*)(op + col)); }
                    s += (v0[0] * v0[0] + v0[1] * v0[1]) + (v0[2] * v0[2] + v0[3] * v0[3]) + (v1[0] * v1[0] + v1[1] * v1[1]) + (v1[2] * v1[2] + v1[3] * v1[3]); }
                s += __shfl_xor(s, 16); s += __shfl_xor(s, 32);
                if (fq == 0) ssq[((size_t)seg * RS + row) * 32 + u.pn * 4 + wc] = s; } }
    }
};

template <class Epi> __device__ __forceinline__ void run_gemm(unsigned char* smem, const GAS bf16* A, const GAS bf16* Bt, int M, int N, int K, const Epi& E) {
    pg8::Gemm g; g.A = (const bf16*)A; g.Bt = (const bf16*)Bt; g.M = M; g.N = N; g.K = K;
    pg8::StaticOrder S; S.init(M, N, grid_x(), (int)blockIdx.x);
    pg8::gemm_phase<Epi, pg8::StaticOrder, true, true>((PG8_LAS unsigned char*)smem, g, S, E);
}

__device__ __forceinline__ void p0_transpose_item(const float* W, int Nsrc, int K, const float* gain, GAS bf16* WT, int k0, int n0d, int n0s, float* scr, int lane) {
    float v[32];
    const float* wp = W + (size_t)(k0 + (lane >> 5)) * Nsrc + n0s + (lane & 31);
#pragma unroll
    for (int i = 0; i < 32; ++i) v[i] = __builtin_nontemporal_load((const GAS float*)wp + (size_t)(2 * i) * Nsrc);
    if (gain) {
#pragma unroll
        for (int i = 0; i < 32; ++i) v[i] *= gain[k0 + 2 * i + (lane >> 5)]; }
#pragma unroll
    for (int i = 0; i < 32; ++i) scr[(2 * i + (lane >> 5)) * 33 + (lane & 31)] = v[i];
    LDS_WAIT(); asm volatile("" ::: "memory");
    const int c = lane & 7;
#pragma unroll
    for (int j = 0; j < 4; ++j) { const int n = (lane >> 3) + 8 * j; const float* s = scr + (8 * c) * 33 + n;
        v4u o; o.x = pk2(s[0 * 33], s[1 * 33]); o.y = pk2(s[2 * 33], s[3 * 33]); o.z = pk2(s[4 * 33], s[5 * 33]); o.w = pk2(s[6 * 33], s[7 * 33]);
        *(GAS v4u*)(WT + (size_t)(n0d + n) * K + k0 + 8 * c) = o; }
    LDS_WAIT(); asm volatile("" ::: "memory");
}
__device__ __forceinline__ void phase_prep(const Params& P, unsigned char* smem) {
    const int tidl = launder_v(threadIdx.x); const int lane = tidl & 63, wave = tidl >> 6;
    const int gw = blockIdx.x * 8 + wave, NGW = grid_x() * 8;
    float* scr = (float*)(smem + wave * 8448);
    gws_t ws = launder_s(P.ws);
    constexpr int I_IN = (DM / 64) * (NWIN / 32), I_A = (DM / 64) * (DM / 32), I_M = (DINNER / 64) * (DM / 32), I_O = I_A, I_UP = (DM / 64) * (NUP / 32), I_DN = (DFF / 64) * (DM / 32);
    constexpr int NITEMS = I_IN + I_A + I_M + I_O + I_UP + I_DN;
    for (int it = gw; it < NITEMS; it += NGW) {
        int r = it + I_IN; if (r >= NITEMS) r -= NITEMS;
        if (r < I_IN) { const int nblk = NWIN / 32, kb = r / nblk, nb = r % nblk, n0d = nb * 32;
            int n0s; if (n0d < 16384) n0s = n0d; else if (n0d < 20480) n0s = n0d + 64; else n0s = n0d - 4096;
            p0_transpose_item(P.w_in, 20544, DM, P.norm1_g, (GAS bf16*)(ws + WS_WIN), kb * 64, n0d, n0s, scr, lane); continue; } r -= I_IN;
        if (r < I_A) { const int nblk = DM / 32, kb = r / nblk, nb = r % nblk; p0_transpose_item(P.w_a, DM, DM, nullptr, (GAS bf16*)(ws + WS_WA), kb * 64, nb * 32, nb * 32, scr, lane); continue; } r -= I_A;
        if (r < I_M) { const int nblk = DM / 32, kb = r / nblk, nb = r % nblk; p0_transpose_item(P.w_m, DM, DINNER, P.mb_norm_g, (GAS bf16*)(ws + WS_WM), kb * 64, nb * 32, nb * 32, scr, lane); continue; } r -= I_M;
        if (r < I_O) { const int nblk = DM / 32, kb = r / nblk, nb = r % nblk; p0_transpose_item(P.w_o, DM, DM, nullptr, (GAS bf16*)(ws + WS_WO), kb * 64, nb * 32, nb * 32, scr, lane); continue; } r -= I_O;
        if (r < I_UP) { const int nblk = NUP / 32, kb = r / nblk, nb = r % nblk, n0d = nb * 32, t = n0d >> 8, j = n0d & 255;
            const int n0s = (j < 128) ? 128 * t + j : DFF + 128 * t + (j - 128);
            p0_transpose_item(P.w_up, NUP, DM, P.norm2_g, (GAS bf16*)(ws + WS_WUP), kb * 64, n0d, n0s, scr, lane); continue; } r -= I_UP;
        { const int nblk = DM / 32, kb = r / nblk, nb = r % nblk; p0_transpose_item(P.w_down, DM, DFF, nullptr, (GAS bf16*)(ws + WS_WDN), kb * 64, nb * 32, nb * 32, scr, lane); }
    }
    GAS bf16* xb = (GAS bf16*)(ws + WS_XB); GAS float* rstd1 = (GAS float*)(ws + WS_RSTD1);
    for (int it2 = gw; it2 < NSEG * RSB; it2 += NGW) {
        const int s = NSEG - 1 - it2 / RSB, lr = it2 % RSB, rid = s * RSB + lr; const float* src = nullptr;
        if (lr < RS) src = P.x + ((size_t)(lr / TSEG) * SEQ + (size_t)s * TSEG + (lr % TSEG)) * DM;
        else if (s == 0) { if (lr >= RS + 48 && lr < RS + 64) src = P.meta + (size_t)(lr - RS - 48) * DM; }
        else continue;
        GAS v2u* o8 = (GAS v2u*)(xb + (size_t)rid * DM) + lane; float ss = 0.f;
        if (src) { const f32x4* xr = (const f32x4*)src + lane;
#pragma unroll
            for (int j = 0; j < 8; ++j) { const f32x4 v = __builtin_nontemporal_load((const GAS f32x4*)xr + 64 * j); ss += (v[0] * v[0] + v[1] * v[1]) + (v[2] * v[2] + v[3] * v[3]); v2u o; o.x = cvt_pk_bf16(v[0], v[1]); o.y = cvt_pk_bf16(v[2], v[3]); o8[64 * j] = o; } }
        else {
#pragma unroll
            for (int j = 0; j < 8; ++j) { v2u o; o.x = 0u; o.y = 0u; o8[64 * j] = o; } }
        ss = wave_sum(ss);
        if (lane == 0) rstd1[rid] = rsqrtf(ss * (1.f / DM) + EPS);
    }
}

__device__ __forceinline__ void phase_conv(const Params& P, int seg) {
    gws_t ws = launder_s(P.ws);
    const GAS bf16* proj = (const GAS bf16*)(ws + WS_PROJ); GAS bf16* ya = (GAS bf16*)(ws + WS_YA); GAS bf16* xconv = (GAS bf16*)(ws + WS_XCONV);
    const GAS bf16* carry_rd = (const GAS bf16*)(ws + WS_CPROJ) + (size_t)(seg & 1) * (2 * 3 * NPROJ);
    GAS bf16* carry_wr = (GAS bf16*)(ws + WS_CPROJ) + (size_t)((seg + 1) & 1) * (2 * 3 * NPROJ);
    const int nruns = RS / 16 + (seg == 0 ? 1 : 0);
    if (__builtin_amdgcn_readfirstlane(threadIdx.x) >= 256) __builtin_amdgcn_s_setprio(1);
    const int gtid = blockIdx.x * NTHREADS + launder_v(threadIdx.x), NT = grid_x() * NTHREADS;
    auto prow = [&](int lr, int k) -> const GAS bf16* {
        if (lr >= RS) return proj + (size_t)(lr - k) * NPROJ;
        const int tt = lr & (TSEG - 1);
        if (tt >= k) return proj + (size_t)(lr - k) * NPROJ;
        if (seg == 0) return proj + (size_t)(RS + 64 + tt - k) * NPROJ;
        return carry_rd + (size_t)((lr / TSEG) * 3 + 3 + tt - k) * NPROJ;
    };
    for (int idx = gtid; idx < nruns * (DXBC / 8); idx += NT) {
        const int r = idx / (DXBC / 8), c = (idx % (DXBC / 8)) * 8, lr0 = (r < RS / 16) ? r * 16 : RS + 48;
        float w0[8], w1[8], w2[8], w3[8], bb[8];
#pragma unroll
        for (int e = 0; e < 8; ++e) { w0[e] = P.mb_conv_w[0 * DXBC + c + e]; w1[e] = P.mb_conv_w[1 * DXBC + c + e]; w2[e] = P.mb_conv_w[2 * DXBC + c + e]; w3[e] = P.mb_conv_w[3 * DXBC + c + e]; bb[e] = P.mb_conv_b[c + e]; }
        float x0[8], x1[8], x2[8], x3[8];
        unpack8(*(const GAS v4u*)(prow(lr0, 3) + OFF_XBC + c), x0); unpack8(*(const GAS v4u*)(prow(lr0, 2) + OFF_XBC + c), x1); unpack8(*(const GAS v4u*)(prow(lr0, 1) + OFF_XBC + c), x2);
#pragma unroll
        for (int hb = 0; hb < 2; ++hb) { v4u raw[8];
#pragma unroll
            for (int i = 0; i < 8; ++i) raw[i] = __builtin_nontemporal_load((const GAS v4u*)(proj + (size_t)(lr0 + hb * 8 + i) * NPROJ + OFF_XBC + c));
#pragma unroll
            for (int i = 0; i < 8; ++i) { unpack8(raw[i], x3); float y[8];
#pragma unroll
                for (int e = 0; e < 8; ++e) { y[e] = siluf_(bb[e] + w0[e] * x0[e] + w1[e] * x1[e] + w2[e] * x2[e] + w3[e] * x3[e]); x0[e] = x1[e]; x1[e] = x2[e]; x2[e] = x3[e]; }
                *(GAS v4u*)(xconv + (size_t)(lr0 + hb * 8 + i) * DXBC + c) = pack8(y); } }
    }
    for (int idx = gtid; idx < nruns * (DM / 8); idx += NT) {
        const int r = idx / (DM / 8), c = (idx % (DM / 8)) * 8, lr0 = (r < RS / 16) ? r * 16 : RS + 48;
        float w0[8], w1[8], w2[8];
#pragma unroll
        for (int e = 0; e < 8; ++e) { w0[e] = P.sc_conv_w[0 * DM + c + e]; w1[e] = P.sc_conv_w[1 * DM + c + e]; w2[e] = P.sc_conv_w[2 * DM + c + e]; }
        float p0[8], p1[8], p2[8], t0[8], t1[8];
        { const GAS bf16* q = prow(lr0, 2); unpack8(*(const GAS v4u*)(q + OFF_SCC + c), t0); unpack8(*(const GAS v4u*)(q + OFF_SCH + c), t1);
#pragma unroll
          for (int e = 0; e < 8; ++e) p0[e] = t0[e] * t1[e]; }
        { const GAS bf16* q = prow(lr0, 1); unpack8(*(const GAS v4u*)(q + OFF_SCC + c), t0); unpack8(*(const GAS v4u*)(q + OFF_SCH + c), t1);
#pragma unroll
          for (int e = 0; e < 8; ++e) p1[e] = t0[e] * t1[e]; }
#pragma unroll
        for (int hb = 0; hb < 4; ++hb) { v4u rc[4], rh[4], rb[4];
#pragma unroll
            for (int i = 0; i < 4; ++i) { const GAS bf16* q = proj + (size_t)(lr0 + hb * 4 + i) * NPROJ; rc[i] = __builtin_nontemporal_load((const GAS v4u*)(q + OFF_SCC + c)); rh[i] = __builtin_nontemporal_load((const GAS v4u*)(q + OFF_SCH + c)); rb[i] = __builtin_nontemporal_load((const GAS v4u*)(q + OFF_SCB + c)); }
#pragma unroll
            for (int i = 0; i < 4; ++i) { float bv[8], y[8]; unpack8(rc[i], t0); unpack8(rh[i], t1); unpack8(rb[i], bv);
#pragma unroll
                for (int e = 0; e < 8; ++e) { p2[e] = t0[e] * t1[e]; y[e] = bv[e] * (w0[e] * p0[e] + w1[e] * p1[e] + w2[e] * p2[e]); p0[e] = p1[e]; p1[e] = p2[e]; }
                *(GAS v4u*)(ya + (size_t)(lr0 + hb * 4 + i) * DM + c) = pack8(y); } }
    }
    if (seg == 0)
        for (int idx = gtid; idx < 48 * (DXBC / 8); idx += NT) { v4u z; z.x = 0u; z.y = 0u; z.z = 0u; z.w = 0u; *(GAS v4u*)(xconv + (size_t)(RS + idx / (DXBC / 8)) * DXBC + (idx % (DXBC / 8)) * 8) = z; }
    { const GAS float* dtv = (const GAS float*)(ws + WS_DT); GAS float* acv = (GAS float*)(ws + WS_ACUM); const int nch = RS / 64 + (seg == 0 ? 1 : 0);
      for (int idx = gtid; idx < nch * 64; idx += NT) { const int c = idx >> 6, hd = idx & 63, r0 = (c < RS / 64) ? c * 64 : RS; const float Ah = -__expf(P.a_log[hd]); float acc = 0.f;
#pragma unroll 16
          for (int i = 0; i < 64; ++i) { acc += dtv[(size_t)(r0 + i) * 64 + hd] * Ah; acv[(size_t)(r0 + i) * 64 + hd] = acc; } } }
    if (seg + 1 < NSEG)
        for (int idx = gtid; idx < 2 * 3 * (NPROJ / 8); idx += NT) { const int c8 = idx % (NPROJ / 8), rk = idx / (NPROJ / 8), b = rk / 3, k = rk % 3;
            *(GAS v4u*)(carry_wr + (size_t)rk * NPROJ + c8 * 8) = *(const GAS v4u*)(proj + (size_t)(b * TSEG + TSEG - 3 + k) * NPROJ + c8 * 8); }
    __builtin_amdgcn_s_setprio(0);
}

constexpr int T_CS = 0, T_BS = T_CS + 64 * 272, T_XD = T_BS + 64 * 272, T_XE = T_XD + 64 * 80, T_XS = T_XE + 64 * 80, T_ZS = T_XS + 64 * 64, T_BUF = T_ZS + 64 * 64;
constexpr int T_ST = 2 * T_BUF, T_STSZ = 32 * 272, T_AC = T_ST + 2 * T_STSZ, T_END = T_AC + 2 * 256;
static_assert(T_END <= LDS_STAGE, "SSD LDS map");
__device__ __forceinline__ f32x4 mfma16(const bf16x8& a, const bf16x8& b, const f32x4& c) { return __builtin_amdgcn_mfma_f32_16x16x32_bf16(a, b, c, 0, 0, 0); }
#define BAR_LDS() do { asm volatile("s_waitcnt lgkmcnt(0)" ::: "memory"); __builtin_amdgcn_s_barrier(); asm volatile("" ::: "memory"); } while (0)
#define TR_ISSUE(dst, addr) asm volatile("ds_read_b64_tr_b16 %0, %1" : "=v"(dst) : "v"(addr) : "memory")
__device__ __forceinline__ bf16x8 mk8(const v2u& lo, const v2u& hi) { v4u t; t.x = lo.x; t.y = lo.y; t.z = hi.x; t.w = hi.y; return __builtin_bit_cast(bf16x8, t); }
__device__ __forceinline__ void phase_ssd(const Params& P, int seg, unsigned char* smem) {
    gws_t ws = launder_s(P.ws);
    const GAS bf16* proj = (const GAS bf16*)(ws + WS_PROJ); const GAS bf16* xconv = (const GAS bf16*)(ws + WS_XCONV); const GAS float* dtv = (const GAS float*)(ws + WS_DT); const GAS float* acv = (const GAS float*)(ws + WS_ACUM);
    GAS bf16* ypre = (GAS bf16*)(ws + WS_YPRE); GAS float* state = (GAS float*)(ws + WS_STATE);
    const int tid = launder_v(threadIdx.x), lane = tid & 63, w = tid >> 6, fr = lane & 15, fq = lane >> 4;
    const unsigned lds0 = (unsigned)(size_t)(LAS unsigned char*)smem;
    bf16* StS = (bf16*)(smem + T_ST); float* acS = (float*)(smem + T_AC);
    const int lt = w >> 1, pt = w & 1, tq = (lane & 15) >> 2, tp = lane & 3;
    if (__builtin_amdgcn_readfirstlane(tid) >= 256) __builtin_amdgcn_s_setprio(1);
    const int gx = grid_x();
    for (int item = blockIdx.x; item < 256; item += gx) {
        const int xcd = item & 7, ix = item >> 3, bg = xcd * 2 + (ix >> 4), b = bg >> 3, g = bg & 7, h = g * 8 + ((ix & 15) >> 1), ph = ix & 1;
        const float Dh = P.d_skip[h];
        const GAS float* stg = state + (size_t)(seg & 1) * (2 * 64 * 64 * 128) + ((size_t)(b * 64 + h) * 64 + ph * 32) * 128;
        GAS float* stw = state + (size_t)((seg + 1) & 1) * (2 * 64 * 64 * 128) + ((size_t)(b * 64 + h) * 64 + ph * 32) * 128;
        f32x4 st[2];
#pragma unroll
        for (int p2 = 0; p2 < 2; ++p2)
#pragma unroll
            for (int j = 0; j < 4; ++j) st[p2][j] = (seg == 0) ? 0.f : stg[(size_t)(p2 * 16 + fq * 4 + j) * 128 + w * 16 + fr];
        __syncthreads();
#pragma unroll
        for (int p2 = 0; p2 < 2; ++p2)
#pragma unroll
            for (int j = 0; j < 4; ++j) StS[(p2 * 16 + fq * 4 + j) * 136 + w * 16 + fr] = (bf16)f2bf(st[p2][j]);
        const int nchunks = TSEG / 64 + (seg == 0 ? 1 : 0);
        struct Pre { v4u Br[2], Cr[2]; v2u Xr, Zr; float dtl, acl, alast, aclane; }; Pre RA, RB;
        auto chunk_row0 = [&](int ci) -> int { return (seg == 0) ? (ci == 0 ? RS : b * TSEG + (ci - 1) * 64) : b * TSEG + ci * 64; };
        auto load_chunk = [&](int ci, Pre& R) { const int row0 = chunk_row0(ci);
#pragma unroll
            for (int i = 0; i < 2; ++i) { const int q = tid + 512 * i, l = q >> 4, c8 = q & 15; const GAS bf16* rp = xconv + (size_t)(row0 + l) * DXBC + g * 128 + c8 * 8;
                R.Br[i] = *(const GAS v4u*)(rp + 4096); R.Cr[i] = *(const GAS v4u*)(rp + 5120); }
            { const int l = tid >> 3, p4 = (tid & 7) * 4; R.Xr = *(const GAS v2u*)(xconv + (size_t)(row0 + l) * DXBC + h * 64 + ph * 32 + p4);
              R.Zr = __builtin_nontemporal_load((const GAS v2u*)(proj + (size_t)(row0 + l) * NPROJ + OFF_Z + h * 64 + ph * 32 + p4));
              R.dtl = dtv[(size_t)(row0 + l) * 64 + h]; R.acl = acv[(size_t)(row0 + l) * 64 + h]; }
            R.alast = acv[(size_t)(row0 + 63) * 64 + h]; R.aclane = acv[(size_t)(row0 + lane) * 64 + h]; };
        load_chunk(0, RA); if (nchunks > 1) load_chunk(1, RB);
        auto step = [&](int ci, Pre& R, const int par) {
            const int row0 = chunk_row0(ci); unsigned char* sb = smem + par * T_BUF; float* acP = acS + par * 64;
            const bf16* StR = StS + par * (T_STSZ / 2); bf16* StW = StS + (par ^ 1) * (T_STSZ / 2);
            const float dec = __expf(R.alast);
            { const float e2 = __expf(R.alast - R.acl);
#pragma unroll
              for (int i = 0; i < 2; ++i) { const int q = tid + 512 * i, l = q >> 4, c8 = q & 15; *(v4u*)(sb + T_CS + l * 272 + c8 * 16) = R.Cr[i]; *(v4u*)(sb + T_BS + l * 272 + c8 * 16) = R.Br[i]; }
              const int l = tid >> 3, p4 = (tid & 7) * 4;
              const float x0 = bflo(R.Xr.x) * R.dtl, x1 = bfhi(R.Xr.x) * R.dtl, x2 = bflo(R.Xr.y) * R.dtl, x3 = bfhi(R.Xr.y) * R.dtl;
              v2u d; d.x = cvt_pk_bf16(x0, x1); d.y = cvt_pk_bf16(x2, x3); *(v2u*)(sb + T_XD + l * 80 + p4 * 2) = d;
              v2u e; e.x = cvt_pk_bf16(x0 * e2, x1 * e2); e.y = cvt_pk_bf16(x2 * e2, x3 * e2); *(v2u*)(sb + T_XE + l * 80 + p4 * 2) = e;
              *(v2u*)(sb + T_XS + l * 64 + p4 * 2) = R.Xr; *(v2u*)(sb + T_ZS + l * 64 + p4 * 2) = R.Zr;
              if (w == 0) acP[lane] = R.aclane; }
            BAR_LDS();
            if (ci + 2 < nchunks) load_chunk(ci + 2, R);
            bf16x8 cf[4];
#pragma unroll
            for (int k = 0; k < 4; ++k) cf[k] = *(const bf16x8*)(sb + T_CS + (lt * 16 + fr) * 272 + (k * 32 + fq * 8) * 2);
            f32x4 yo = {0.f, 0.f, 0.f, 0.f};
#pragma unroll
            for (int k = 0; k < 4; ++k) { const bf16x8 bb = *(const bf16x8*)((const unsigned char*)StR + (pt * 16 + fr) * 272 + (k * 32 + fq * 8) * 2); yo = mfma16(cf[k], bb, yo); }
{ const f32x4 a4 = *(const f32x4*)(acP + lt * 16 + fq * 4);
#pragma unroll
              for (int j = 0; j < 4; ++j) yo[j] *= __expf(a4[j]); }
            const float acl_fr = acP[lt * 16 + fr]; const int lrow = lt * 16 + fr;
#pragma unroll
            for (int t = 0; t < 2; ++t) {
                if (2 * t <= lt) {
                    v2u xb0, xb1;
                    { const unsigned a0 = lds0 + par * T_BUF + T_XD + (32 * t + 4 * fq + tq) * 80 + (pt * 16 + 4 * tp) * 2, a1 = a0 + 16 * 80; TR_ISSUE(xb0, a0); TR_ISSUE(xb1, a1); }
                    float m[8];
                    { f32x4 s0 = {0.f, 0.f, 0.f, 0.f}, s1 = {0.f, 0.f, 0.f, 0.f};
#pragma unroll
                      for (int k = 0; k < 4; ++k) { const bf16x8 bf0 = *(const bf16x8*)(sb + T_BS + ((2 * t) * 16 + fr) * 272 + (k * 32 + fq * 8) * 2), bf1 = *(const bf16x8*)(sb + T_BS + ((2 * t + 1) * 16 + fr) * 272 + (k * 32 + fq * 8) * 2);
                          s0 = mfma16(bf0, cf[k], s0); s1 = mfma16(bf1, cf[k], s1); }
                      const f32x4 a0 = *(const f32x4*)(acP + (2 * t) * 16 + fq * 4), a1 = *(const f32x4*)(acP + (2 * t + 1) * 16 + fq * 4);
#pragma unroll
                      for (int j = 0; j < 4; ++j) { const int si0 = (2 * t) * 16 + fq * 4 + j, si1 = si0 + 16;
                          const float e0 = s0[j] * __expf(fminf(acl_fr - a0[j], 0.f)), e1 = s1[j] * __expf(fminf(acl_fr - a1[j], 0.f));
                          m[j] = (si0 <= lrow) ? e0 : 0.f; m[4 + j] = (si1 <= lrow) ? e1 : 0.f; } }
                    v4u mp; mp.x = cvt_pk_bf16(m[0], m[1]); mp.y = cvt_pk_bf16(m[2], m[3]); mp.z = cvt_pk_bf16(m[4], m[5]); mp.w = cvt_pk_bf16(m[6], m[7]);
                    asm volatile("s_waitcnt lgkmcnt(0)" : "+v"(xb0), "+v"(xb1) :: "memory");
                    yo = mfma16(__builtin_bit_cast(bf16x8, mp), mk8(xb0, xb1), yo);
                }
            }
#pragma unroll
            for (int j = 0; j < 4; ++j) { const int l = lt * 16 + fq * 4 + j, p = pt * 16 + fr; const float xv = bf2f(*(const bf16*)(sb + T_XS + l * 64 + p * 2)), zv = bf2f(*(const bf16*)(sb + T_ZS + l * 64 + p * 2));
                ypre[(size_t)(row0 + l) * DINNER + h * 64 + ph * 32 + p] = f2bfh((yo[j] + Dh * xv) * siluf_(zv)); }
            { v2u xa[2][2][2], bb[2][2];
#pragma unroll
              for (int kk = 0; kk < 2; ++kk) {
#pragma unroll
                  for (int hh = 0; hh < 2; ++hh) { const int r = kk * 32 + 8 * fq + 4 * hh + tq;
                      TR_ISSUE(bb[kk][hh], lds0 + par * T_BUF + T_BS + r * 272 + (w * 16 + 4 * tp) * 2);
#pragma unroll
                      for (int p2 = 0; p2 < 2; ++p2) TR_ISSUE(xa[p2][kk][hh], lds0 + par * T_BUF + T_XE + r * 80 + (p2 * 16 + 4 * tp) * 2); } }
              asm volatile("s_waitcnt lgkmcnt(0)" : "+v"(xa[0][0][0]), "+v"(xa[0][0][1]), "+v"(xa[0][1][0]), "+v"(xa[0][1][1]), "+v"(xa[1][0][0]), "+v"(xa[1][0][1]), "+v"(xa[1][1][0]), "+v"(xa[1][1][1]),
                           "+v"(bb[0][0]), "+v"(bb[0][1]), "+v"(bb[1][0]), "+v"(bb[1][1]) :: "memory");
#pragma unroll
              for (int p2 = 0; p2 < 2; ++p2) { st[p2] *= dec;
#pragma unroll
                  for (int kk = 0; kk < 2; ++kk) st[p2] = mfma16(mk8(xa[p2][kk][0], xa[p2][kk][1]), mk8(bb[kk][0], bb[kk][1]), st[p2]); } }
#pragma unroll
            for (int p2 = 0; p2 < 2; ++p2)
#pragma unroll
                for (int j = 0; j < 4; ++j) StW[(p2 * 16 + fq * 4 + j) * 136 + w * 16 + fr] = (bf16)f2bf(st[p2][j]);
        };
        for (int ci = 0; ci < nchunks; ci += 2) { step(ci, RA, 0); if (ci + 1 < nchunks) step(ci + 1, RB, 1); }
        if (seg + 1 < NSEG) {
#pragma unroll
            for (int p2 = 0; p2 < 2; ++p2)
#pragma unroll
                for (int j = 0; j < 4; ++j) stw[(size_t)(p2 * 16 + fq * 4 + j) * 128 + w * 16 + fr] = st[p2][j]; }
        __syncthreads();
    }
    __builtin_amdgcn_s_setprio(0);
}

__device__ __forceinline__ void phase_gnorm(const Params& P, int seg) {
    GAS bf16* ypre = (GAS bf16*)(launder_s(P.ws) + WS_YPRE);
    const int tidl = launder_v(threadIdx.x); const int lane = tidl & 63, gw = blockIdx.x * 8 + (tidl >> 6), NGW = grid_x() * 8;
    const int nrows = (seg == 0) ? RS + 16 : RS;
    for (int rr = gw; rr < nrows; rr += NGW) { const int row = (rr < RS) ? rr : rr + 48; GAS bf16* p = ypre + (size_t)row * DINNER + lane * 8;
        v4u raw[8];
#pragma unroll
        for (int g = 0; g < 8; ++g) raw[g] = *(const GAS v4u*)(p + g * 512);
#pragma unroll
        for (int g = 0; g < 8; ++g) { float f[8]; unpack8(raw[g], f); float s = 0.f;
#pragma unroll
            for (int e = 0; e < 8; ++e) s += f[e] * f[e];
            s = wave_sum(s); const float rs = rsqrtf(s * (1.f / 512.f) + EPS);
#pragma unroll
            for (int e = 0; e < 8; ++e) f[e] *= rs;
            *(GAS v4u*)(p + g * 512) = pack8(f); } }
}

__device__ __forceinline__ void phase_ffnfix(const Params& P, int seg) {
    gws_t ws = launder_s(P.ws);
    GAS bf16* act = (GAS bf16*)(ws + WS_ACT);
    const GAS float* eu = (const GAS float*)(ws + WS_EU) + (size_t)(seg & 1) * (32 * 4 * DFF); const GAS float* eup = (const GAS float*)(ws + WS_EU) + (size_t)((seg + 1) & 1) * (32 * 4 * DFF);
    const GAS float* ev = (const GAS float*)(ws + WS_EV); const GAS float* um = (const GAS float*)(ws + WS_UMETA);
    const int gtid = blockIdx.x * NTHREADS + launder_v(threadIdx.x), NT = grid_x() * NTHREADS;
    for (int idx = gtid; idx < 32 * DFF; idx += NT) { const int pm = idx / DFF, c = idx % DFF;
        const GAS float* hp;
        if (pm & 15) hp = eu + (size_t)(pm - 1) * 4 * DFF; else if (seg > 0) hp = eup + (size_t)(pm + 15) * 4 * DFF; else hp = nullptr;
        const float h0 = hp ? hp[c] : um[c], h1 = hp ? hp[DFF + c] : um[DFF + c];
        const float u0 = eu[((size_t)pm * 4 + 2) * DFF + c], u1 = eu[((size_t)pm * 4 + 3) * DFF + c], v0 = ev[((size_t)pm * 2 + 0) * DFF + c], v1 = ev[((size_t)pm * 2 + 1) * DFF + c];
        const float w0 = P.ffn_conv_w[c], w1 = P.ffn_conv_w[DFF + c], w2 = P.ffn_conv_w[2 * DFF + c], bb = P.ffn_conv_b[c];
        act[(size_t)(pm * 256) * DFF + c] = (bf16)f2bf(siluf_(bb + w0 * h0 + w1 * h1 + w2 * u0) * v0);
        act[(size_t)(pm * 256 + 1) * DFF + c] = (bf16)f2bf(siluf_(bb + w0 * h1 + w1 * u0 + w2 * u1) * v1); }
}

__device__ __forceinline__ void phase_final(const Params& P, int sg, int blk0) {
    const GAS float* ssq3 = (const GAS float*)(launder_s(P.ws) + WS_SSQ3);
    const int tidl = launder_v(threadIdx.x); const int lane = tidl & 63, gw = ((int)blockIdx.x - blk0) * 8 + (tidl >> 6), NGW = (grid_x() - blk0) * 8;
    if (gw < 0) return;
    f32x4 gf[4][2];
#pragma unroll
    for (int i = 0; i < 4; ++i) { gf[i][0] = ((const f32x4*)P.normf_g)[2 * (lane + 64 * i)]; gf[i][1] = ((const f32x4*)P.normf_g)[2 * (lane + 64 * i) + 1]; }
    for (int lr = gw; lr < RS; lr += NGW) { const int rid = (lr / TSEG) * SEQ + sg * TSEG + (lr % TSEG);
        float s = (lane < 32) ? ssq3[((size_t)sg * RS + lr) * 32 + lane] : 0.f; s = wave_sum(s);
        const float rs = rsqrtf(s * (1.f / DM) + EPS);
        GAS float* orow = (GAS float*)P.out + (size_t)rid * DM;
        v4u hb[4];
#pragma unroll
        for (int i = 0; i < 4; ++i) hb[i] = __builtin_nontemporal_load((const GAS v4u*)orow + lane + 64 * i);
        __builtin_amdgcn_s_waitcnt(0x0070);
#pragma unroll
        for (int i = 0; i < 4; ++i) { float f[8]; unpack8(hb[i], f); const int c = lane + 64 * i;
            const f32x4 a = (f32x4){f[0], f[1], f[2], f[3]} * rs * gf[i][0], d = (f32x4){f[4], f[5], f[6], f[7]} * rs * gf[i][1];
            __builtin_nontemporal_store(a, (GAS f32x4*)orow + 2 * c); __builtin_nontemporal_store(d, (GAS f32x4*)orow + 2 * c + 1); } }
}


template <class F> __device__ __forceinline__ void skinny_tile(const GAS bf16* A, int lda, const GAS bf16* Bt, int K, int n0, int lane, F&& epi) {
    const int fr = lane & 15, fq = lane >> 4;
    const GAS bf16* ap = A + (size_t)fr * lda + fq * 8; const GAS bf16* bp = Bt + (size_t)(n0 + fr) * K + fq * 8;
    f32x4 acc0 = {0.f, 0.f, 0.f, 0.f}, acc1 = {0.f, 0.f, 0.f, 0.f};
    bf16x8 a[4], bb[4], a2[4], b2[4];
#pragma unroll
    for (int i = 0; i < 4; ++i) { a[i] = *(const GAS bf16x8*)(ap + i * 32); bb[i] = *(const GAS bf16x8*)(bp + i * 32); }
    for (int k = 0; k < K; k += 256) {
#pragma unroll
        for (int i = 0; i < 4; ++i) { a2[i] = *(const GAS bf16x8*)(ap + k + 128 + i * 32); b2[i] = *(const GAS bf16x8*)(bp + k + 128 + i * 32); }
#pragma unroll
        for (int i = 0; i < 4; i += 2) { acc0 = mfma16(a[i], bb[i], acc0); acc1 = mfma16(a[i + 1], bb[i + 1], acc1); }
        if (k + 256 < K) {
#pragma unroll
            for (int i = 0; i < 4; ++i) { a[i] = *(const GAS bf16x8*)(ap + k + 256 + i * 32); bb[i] = *(const GAS bf16x8*)(bp + k + 256 + i * 32); } }
#pragma unroll
        for (int i = 0; i < 4; i += 2) { acc0 = mfma16(a2[i], b2[i], acc0); acc1 = mfma16(a2[i + 1], b2[i + 1], acc1); } }
#pragma unroll
    for (int j = 0; j < 4; ++j) epi(fq * 4 + j, j, n0 + fr, acc0[j] + acc1[j]);
}
template <class F> __device__ __forceinline__ void skinny_tile_sk(const GAS bf16* A, int lda, const GAS bf16* Bt, int K, int n0, int wave, int lane, float* red, F&& epi) {
    const int fr = lane & 15, fq = lane >> 4, kc = K >> 3;
    const GAS bf16* ap = A + (size_t)fr * lda + wave * kc + fq * 8; const GAS bf16* bp = Bt + (size_t)(n0 + fr) * K + wave * kc + fq * 8;
    f32x4 acc0 = {0.f, 0.f, 0.f, 0.f}, acc1 = {0.f, 0.f, 0.f, 0.f};
    for (int k = 0; k < kc; k += 256) { bf16x8 a[8], bb[8];
#pragma unroll
        for (int i = 0; i < 8; ++i) { a[i] = *(const GAS bf16x8*)(ap + k + i * 32); bb[i] = *(const GAS bf16x8*)(bp + k + i * 32); }
#pragma unroll
        for (int i = 0; i < 8; i += 2) { acc0 = mfma16(a[i], bb[i], acc0); acc1 = mfma16(a[i + 1], bb[i + 1], acc1); } }
    __syncthreads();
    *(f32x4*)(red + wave * 256 + lane * 4) = acc0 + acc1;
    __syncthreads();
    if (wave == 0) { f32x4 s = {0.f, 0.f, 0.f, 0.f};
#pragma unroll
        for (int w = 0; w < 8; ++w) s += *(const f32x4*)(red + w * 256 + lane * 4);
#pragma unroll
        for (int j = 0; j < 4; ++j) epi(fq * 4 + j, j, n0 + fr, s[j]); }
}
__device__ __forceinline__ void side_gemm1(const Params& P, int seg) {
    gws_t ws = launder_s(P.ws);
    const int tidl = launder_v(threadIdx.x), lane = tidl & 63, gw = blockIdx.x * 8 + (tidl >> 6), NGW = grid_x() * 8;
    const GAS bf16* xb = (const GAS bf16*)(ws + WS_XB) + (size_t)seg * RSB * DM; const GAS float* rstd1 = (const GAS float*)(ws + WS_RSTD1) + (size_t)seg * RSB;
    const GAS bf16* Wt = (const GAS bf16*)(ws + WS_WIN); GAS float* dtv = (GAS float*)(ws + WS_DT); GAS bf16* proj = (GAS bf16*)(ws + WS_PROJ);
    const int nrt = RS / 16 + (seg == 0 ? 1 : 0);
    for (int it = gw; it < nrt * 4; it += NGW) { const int rt = it >> 2, r0 = (rt < RS / 16) ? rt * 16 : RS + 48;
        skinny_tile(xb + (size_t)r0 * DM, DM, Wt + (size_t)NPROJ * DM, DM, (it & 3) * 16, lane, [&](int row, int j, int col, float v) {
            const float t = v * rstd1[r0 + row] + P.dt_bias[col]; dtv[(size_t)(r0 + row) * 64 + col] = (t > 20.f) ? t : log1pf(__expf(t)); }); }
    if (seg == 0) {
        for (int it = gw; it < NPROJ / 16; it += NGW)
            skinny_tile(xb + (size_t)(RS + 48) * DM, DM, Wt, DM, it * 16, lane, [&](int row, int j, int col, float v) { proj[(size_t)(RS + 48 + row) * NPROJ + col] = (bf16)f2bf(v * rstd1[RS + 48 + row]); });
        const int gtid = blockIdx.x * NTHREADS + tidl, NT = grid_x() * NTHREADS;
        for (int idx = gtid; idx < 3 * (NPROJ / 8); idx += NT) { v4u z; z.x = 0u; z.y = 0u; z.z = 0u; z.w = 0u; *(GAS v4u*)(proj + (size_t)(RS + 45 + idx / (NPROJ / 8)) * NPROJ + (idx % (NPROJ / 8)) * 8) = z; }
        for (int idx = gtid; idx < 48 * 64; idx += NT) dtv[(size_t)RS * 64 + idx] = 0.f;
    }
}
__device__ __forceinline__ void side_gemm2(const Params& P, unsigned char* smem) {
    gws_t ws = launder_s(P.ws);
    const int tidl = launder_v(threadIdx.x), lane = tidl & 63, gw = blockIdx.x * 8 + (tidl >> 6), NGW = grid_x() * 8;
    const GAS bf16* proj = (const GAS bf16*)(ws + WS_PROJ); GAS bf16* ta = (GAS bf16*)(ws + WS_TA);
    for (int it = blockIdx.x; it < DM / 16; it += NGW / 8)
        skinny_tile_sk((const GAS bf16*)(ws + WS_YA) + (size_t)(RS + 48) * DM, DM, (const GAS bf16*)(ws + WS_WA), DM, it * 16, tidl >> 6, lane, (float*)smem, [&](int row, int j, int col, float v) {
            const int r = RS + 48 + row; ta[(size_t)r * DM + col] = (bf16)f2bf(sigmoidf_(bf2f(proj[(size_t)r * NPROJ + OFF_GATE + col]) + P.b_gate[col]) * v); });
}
__device__ __forceinline__ void side_gemm3(const Params& P, unsigned char* smem) {
    gws_t ws = launder_s(P.ws);
    const int tidl = launder_v(threadIdx.x), lane = tidl & 63, gw = blockIdx.x * 8 + (tidl >> 6), NGW = grid_x() * 8;
    const GAS bf16* proj = (const GAS bf16*)(ws + WS_PROJ); const GAS bf16* ta = (const GAS bf16*)(ws + WS_TA); GAS bf16* mix = (GAS bf16*)(ws + WS_MIX);
    for (int it = blockIdx.x; it < DM / 16; it += NGW / 8)
        skinny_tile_sk((const GAS bf16*)(ws + WS_YPRE) + (size_t)(RS + 48) * DINNER, DINNER, (const GAS bf16*)(ws + WS_WM), DINNER, it * 16, tidl >> 6, lane, (float*)smem, [&](int row, int j, int col, float v) {
            const int r = RS + 48 + row; mix[(size_t)r * DM + col] = (bf16)f2bf(bf2f(ta[(size_t)r * DM + col]) + sigmoidf_(bf2f(proj[(size_t)r * NPROJ + OFF_GATE + DM + col]) + P.b_gate[DM + col]) * v); });
}
__device__ __forceinline__ void side_gemm4(const Params& P, unsigned char* smem) {
    gws_t ws = launder_s(P.ws);
    const int tidl = launder_v(threadIdx.x), lane = tidl & 63, gw = blockIdx.x * 8 + (tidl >> 6), NGW = grid_x() * 8;
    GAS bf16* h1b = (GAS bf16*)(ws + WS_H1B); GAS float* ssqm = (GAS float*)(ws + WS_SSQM);
    for (int it = blockIdx.x; it < DM / 16; it += NGW / 8) { float sq0 = 0.f, sq1 = 0.f, sq2 = 0.f, sq3 = 0.f;
        skinny_tile_sk((const GAS bf16*)(ws + WS_MIX) + (size_t)(RS + 48) * DM, DM, (const GAS bf16*)(ws + WS_WO), DM, it * 16, tidl >> 6, lane, (float*)smem, [&](int row, int j, int col, float v) {
            const float hv = P.meta[(size_t)row * DM + col] + v; h1b[(size_t)(RS + 48 + row) * DM + col] = (bf16)f2bf(hv);
            const float q = hv * hv; if (j == 0) sq0 = q; else if (j == 1) sq1 = q; else if (j == 2) sq2 = q; else sq3 = q; });
        float sq[4] = {sq0, sq1, sq2, sq3};
        if ((tidl >> 6) == 0)
#pragma unroll
        for (int j = 0; j < 4; ++j) { float s = sq[j]; s += __shfl_xor(s, 1); s += __shfl_xor(s, 2); s += __shfl_xor(s, 4); s += __shfl_xor(s, 8);
            if ((lane & 15) == 0) ssqm[((lane >> 4) * 4 + j) * 128 + it] = s; } }
}
__device__ __forceinline__ void side_gemm5(const Params& P, unsigned char* smem) {
    gws_t ws = launder_s(P.ws);
    const int tidl = launder_v(threadIdx.x), lane = tidl & 63, gw = blockIdx.x * 8 + (tidl >> 6), NGW = grid_x() * 8;
    const GAS float* ssqm = (const GAS float*)(ws + WS_SSQM); GAS float* um = (GAS float*)(ws + WS_UMETA);
    for (int it = blockIdx.x; it < DFF / 16; it += NGW / 8) {
        float s = 0.f;
        for (int i = 0; i < 32; ++i) s += ssqm[(lane & 15) * 128 + (lane >> 4) * 32 + i];
        s += __shfl_xor(s, 16); s += __shfl_xor(s, 32);
        const float rsl = rsqrtf(s * (1.f / DM) + EPS);
        const float r2 = __shfl(rsl, 14), r3 = __shfl(rsl, 15);
        const int n0 = 256 * (it >> 3) + 16 * (it & 7);
        skinny_tile_sk((const GAS bf16*)(ws + WS_H1B) + (size_t)(RS + 48) * DM, DM, (const GAS bf16*)(ws + WS_WUP), DM, n0, tidl >> 6, lane, (float*)smem, [&](int row, int j, int col, float v) {
            if (row >= 14) um[(size_t)(row - 14) * DFF + 16 * it + (col - n0)] = v * ((row == 14) ? r2 : r3); }); }
}

#define XB_TMO      128
#define XB_XCNT(j)  (256  + 64 * (j))
#define XB_XSUB(j)  (1280 + 64 * (j))
#define XB_XGEN(j)  (2304 + 64 * (j))
#define XB_TOP      3328
#define XB_TOPGEN   3392
#define XCD_BAR_WORDS 3456
#define XB_SPIN_CAP (1u << 18)

__device__ __forceinline__ unsigned xb_ld(unsigned* p)              { return __hip_atomic_load(p, __ATOMIC_RELAXED, __HIP_MEMORY_SCOPE_AGENT); }
__device__ __forceinline__ unsigned xb_add(unsigned* p, unsigned v) { return __hip_atomic_fetch_add(p, v, __ATOMIC_RELAXED, __HIP_MEMORY_SCOPE_AGENT); }
__device__ __forceinline__ unsigned xb_xcc_id() { return (unsigned)__builtin_amdgcn_s_getreg((3 << 11) | 20) & 0xFu; }
#define XB_SPIN(cond, bar) do { unsigned _sp = 0; while (cond) { __builtin_amdgcn_s_sleep(1); \
    if ((++_sp & 255u) == 0u) { if (xb_ld(&(bar)[XB_TMO])) break; if (_sp > XB_SPIN_CAP) { atomicAdd(&(bar)[XB_TMO], 1u); break; } } } } while (0)

struct XcdBarrier {
    unsigned* bar; unsigned x;
    volatile LAS unsigned* st;
};

__device__ __forceinline__ XcdBarrier xcd_barrier_post(unsigned* bar, volatile LAS unsigned* st) {
    XcdBarrier b; b.bar = bar; b.x = xb_xcc_id(); b.st = st;
    if (threadIdx.x == 0) (void)xb_add(&bar[XB_XCNT(b.x)], 1u);
    return b;
}
__device__ __forceinline__ void xcd_barrier_complete(unsigned* bar, unsigned x, unsigned& nloc, unsigned& nx) {
    const unsigned G = gridDim.x * gridDim.y * gridDim.z;
    unsigned sum, cnt, mine, sp = 0u;
    for (;;) {
        sum = 0u; cnt = 0u; mine = 0u;
#pragma unroll
        for (unsigned j = 0; j < 16; ++j) { const unsigned c = xb_ld(&bar[XB_XCNT(j)]); sum += c; cnt += (c > 0u) ? 1u : 0u; mine = (j == x) ? c : mine; }
        if (sum == G) break;
        __builtin_amdgcn_s_sleep(1);
        if ((++sp & 255u) == 0u) { if (xb_ld(&bar[XB_TMO])) break; if (sp > XB_SPIN_CAP) { atomicAdd(&bar[XB_TMO], 1u); break; } }
    }
    nloc = mine > 0u ? mine : 1u; nx = cnt > 0u ? cnt : 1u;
}

__device__ __forceinline__ void xcd_barrier(const XcdBarrier& b) {
    asm volatile("s_waitcnt vmcnt(0)" ::: "memory");
    __syncthreads();
    if (threadIdx.x == 0) {
        unsigned* bar = b.bar;
        __builtin_amdgcn_s_waitcnt(0);
        unsigned nloc = b.st[0], nx = b.st[1];
        if (nloc == 0u) { xcd_barrier_complete(bar, b.x, nloc, nx); b.st[0] = nloc; b.st[1] = nx; }
        const unsigned old = xb_add(&bar[XB_XSUB(b.x)], 1u);
        const unsigned gen = old / nloc;
        if (old + 1u == (gen + 1u) * nloc) {
            __builtin_amdgcn_fence(__ATOMIC_RELEASE, "agent");
            asm volatile("s_waitcnt vmcnt(0)" ::: "memory");
            const unsigned og = xb_add(&bar[XB_TOP], 1u);
            const unsigned tg = og / nx;
            if (og + 1u == (tg + 1u) * nx) xb_add(&bar[XB_TOPGEN], 1u);
            else XB_SPIN(xb_ld(&bar[XB_TOPGEN]) == tg, bar);
            __builtin_amdgcn_fence(__ATOMIC_ACQUIRE, "agent");
            xb_add(&bar[XB_XGEN(b.x)], 1u);
            asm volatile("s_waitcnt vmcnt(0)" ::: "memory");
        } else {
            XB_SPIN(xb_ld(&bar[XB_XGEN(b.x)]) == gen, bar);
            __builtin_amdgcn_fence(__ATOMIC_ACQUIRE, "agent");
            asm volatile("s_waitcnt vmcnt(0)" ::: "memory");
        }
    }
    __syncthreads();
}

#ifndef REP_G1
#define REP_G1 1
#endif
#ifndef REP_SIDE
#define REP_SIDE 1
#endif
#ifndef REP_GX
#define REP_GX 1
#endif
#ifndef REP_P0
#define REP_P0 1
#endif
#ifndef REP_SSD
#define REP_SSD 1
#endif
#ifndef REP_ELT
#define REP_ELT 1
#endif
__global__ void __launch_bounds__(NTHREADS, 2) hybrid_fwd(Params P) {
    extern __shared__ __attribute__((aligned(16))) unsigned char smem[];
    cg::grid_group grid = cg::this_grid();
    gws_t ws = (gws_t)P.ws;
    volatile LAS unsigned* xst = (volatile LAS unsigned*)(smem + LDS_STAGE);
    if (threadIdx.x < 2) xst[threadIdx.x] = 0u;
    __syncthreads();
    if (blockIdx.x == 0) { GAS unsigned* bw = (GAS unsigned*)(ws + WS_BAR);
        for (int i = threadIdx.x; i < XCD_BAR_WORDS; i += NTHREADS) bw[i] = 0u;
        __threadfence(); }
    for (int rep = 0; rep < REP_P0; ++rep) phase_prep(P, smem);
    grid.sync();
    XcdBarrier xb = xcd_barrier_post((unsigned*)(GAS unsigned*)(ws + WS_BAR), xst);
    for (int seg = 0; seg < NSEG; ++seg) {
        ws = launder_s((const void*)ws);
        { Epi1 E; E.O = (GAS bf16*)(ws + WS_PROJ); E.rstd = (const GAS float*)(ws + WS_RSTD1) + (size_t)seg * RSB;
          for (int rep = 0; rep < REP_G1; ++rep) run_gemm(smem, (const GAS bf16*)(ws + WS_XB) + (size_t)seg * RSB * DM, (const GAS bf16*)(ws + WS_WIN), RS, NPROJ, DM, E); }
        for (int rep = 0; rep < REP_SIDE; ++rep) side_gemm1(P, seg);
        xcd_barrier(xb);
        for (int rep = 0; rep < REP_ELT; ++rep) phase_conv(P, seg);
        xcd_barrier(xb);
        for (int rep = 0; rep < REP_SSD; ++rep) phase_ssd(P, seg, smem);
        xcd_barrier(xb);
        phase_gnorm(P, seg);
        ws = launder_s((const void*)ws);
        { EpiGate<0> E; E.proj = (const GAS bf16*)(ws + WS_PROJ); E.bgate = P.b_gate; E.ta = (GAS bf16*)(ws + WS_TA); E.mix = (GAS bf16*)(ws + WS_MIX);
          for (int rep = 0; rep < REP_GX; ++rep) run_gemm(smem, (const GAS bf16*)(ws + WS_YA), (const GAS bf16*)(ws + WS_WA), RS, DM, DM, E); }
        if (seg == 0) side_gemm2(P, smem);
        xcd_barrier(xb);
        ws = launder_s((const void*)ws);
        { EpiGate<1> E; E.proj = (const GAS bf16*)(ws + WS_PROJ); E.bgate = P.b_gate; E.ta = (GAS bf16*)(ws + WS_TA); E.mix = (GAS bf16*)(ws + WS_MIX);
          for (int rep = 0; rep < REP_GX; ++rep) run_gemm(smem, (const GAS bf16*)(ws + WS_YPRE), (const GAS bf16*)(ws + WS_WM), RS, DM, DINNER, E); }
        if (seg == 0) side_gemm3(P, smem);
        xcd_barrier(xb);
        ws = launder_s((const void*)ws);
        { Epi4 E; E.x = P.x; E.meta = P.meta; E.h1b = (GAS bf16*)(ws + WS_H1B); E.ssq = (GAS float*)(ws + WS_SSQ2); E.seg = seg;
          for (int rep = 0; rep < REP_GX; ++rep) run_gemm(smem, (const GAS bf16*)(ws + WS_MIX), (const GAS bf16*)(ws + WS_WO), RS, DM, DM, E); }
        if (seg == 0) side_gemm4(P, smem);
        xcd_barrier(xb);
        ws = launder_s((const void*)ws);
        { Epi5 E; E.act = (GAS bf16*)(ws + WS_ACT); E.ssq = (const GAS float*)(ws + WS_SSQ2); E.cw = P.ffn_conv_w; E.cb = P.ffn_conv_b; E.xch = (LAS float*)(smem + LDS_XCH);
          E.eu = (GAS float*)(ws + WS_EU) + (size_t)(seg & 1) * (32 * 4 * DFF); E.ev = (GAS float*)(ws + WS_EV);
          for (int rep = 0; rep < REP_GX; ++rep) run_gemm(smem, (const GAS bf16*)(ws + WS_H1B), (const GAS bf16*)(ws + WS_WUP), RS, NUP, DM, E); }
        if (seg == 0) side_gemm5(P, smem);
        if (seg > 0) phase_final(P, seg - 1, (RS / 256) * (NUP / 256) - 5 * 256);
        xcd_barrier(xb);
        phase_ffnfix(P, seg);
        xcd_barrier(xb);
        ws = launder_s((const void*)ws);
        { Epi6 E; E.h1 = (const GAS bf16*)(ws + WS_H1B); E.out = P.out; E.ssq = (GAS float*)(ws + WS_SSQ3); E.seg = seg;
          for (int rep = 0; rep < REP_GX; ++rep) run_gemm(smem, (const GAS bf16*)(ws + WS_ACT), (const GAS bf16*)(ws + WS_WDN), RS, DM, DFF, E); }
        xcd_barrier(xb);
    }
    phase_final(P, NSEG - 1, 0);
}

extern "C" void kernel_launch(void* const* d_in, const int* in_sizes, int n_in, void* d_out, int out_size, void* d_ws, size_t ws_size, hipStream_t stream) {
    static int grid_blocks = 0;
    if (grid_blocks == 0) {
        if (n_in != 21 || in_sizes[0] != NBATCH * SEQ * DM || out_size != NBATCH * SEQ * DM || ws_size < WS_END) {
            fprintf(stderr, "kernel_launch: unexpected shapes (n_in %d, in0 %d, out %d, ws %zu, need %zu)\n", n_in, n_in > 0 ? in_sizes[0] : -1, out_size, ws_size, (size_t)WS_END); grid_blocks = -1; return; }
        int dev = 0, cus = 0, per_cu = 0;
        hipGetDevice(&dev); hipDeviceGetAttribute(&cus, hipDeviceAttributeMultiprocessorCount, dev);
        if (hipFuncSetAttribute((const void*)hybrid_fwd, hipFuncAttributeMaxDynamicSharedMemorySize, LDS_BYTES) != hipSuccess) { fprintf(stderr, "kernel_launch: hipFuncSetAttribute failed\n"); grid_blocks = -1; return; }
        hipOccupancyMaxActiveBlocksPerMultiprocessor(&per_cu, (const void*)hybrid_fwd, NTHREADS, LDS_BYTES);
        if (per_cu < 1) { fprintf(stderr, "kernel_launch: occupancy query says %d blocks per CU\n", per_cu); per_cu = 1; }
        (void)hipGetLastError();
        grid_blocks = cus * per_cu;
    }
    if (grid_blocks < 0) return;
    Params p{};
    const float** pp = (const float**)&p;
    for (int i = 0; i < 21; ++i) pp[i] = (const float*)d_in[i];
    p.out = (float*)d_out; p.ws = (unsigned char*)d_ws;
    void* args[] = {&p};
    hipError_t e = hipLaunchCooperativeKernel((const void*)hybrid_fwd, dim3(grid_blocks), dim3(NTHREADS), args, LDS_BYTES, stream);
    if (e != hipSuccess) fprintf(stderr, "cooperative launch failed: %s (grid %d)\n", hipGetErrorString(e), grid_blocks);
}
```

```cpp
#include <hip/hip_runtime.h>
#include <hip/hip_cooperative_groups.h>
#include <cstdio>
#include <cstdint>
namespace cg = cooperative_groups;

namespace pg8 {
#define PG8_LAS __attribute__((address_space(3)))
typedef unsigned short bf16_t;
typedef short bf16x8 __attribute__((ext_vector_type(8)));
typedef float f32x4 __attribute__((ext_vector_type(4)));
typedef unsigned u32x4 __attribute__((ext_vector_type(4)));
constexpr int BM = 256, BK = 64, HALF = 128, HTB = HALF * BK * 2  , STAGE_BYTES = 8 * HTB, NXCD = 8, WGM = 8;

__host__ __device__ __forceinline__ int lds_byte(int r, int c) { const int st = (r >> 4) * 2 + (c >> 5), rr = r & 15, cc = c & 31, ob = rr * 64 + cc * 2; return st * 1024 + (ob ^ (((ob >> 9) & 1) << 5)); }
__host__ __device__ __forceinline__ void stage_rc(int b, int& R, int& C) { const int st = b / 1024, sb = b % 1024, swz = sb ^ (((sb >> 9) & 1) << 5); R = (st >> 1) * 16 + swz / 64; C = (st & 1) * 32 + (swz % 64) / 2; }
__host__ __device__ __forceinline__ int perm32(int rho) { const int n = rho >> 4, i = rho & 15; return 8 * (i >> 2) + 4 * n + (i & 3); }

struct Unit { int pm, pn; };
struct Gemm { const bf16_t* A; const bf16_t* Bt; int M, N, K; };

struct StaticOrder {
    int nM, nN, nwg, G, c;
    __host__ __device__ void init(int M, int N, int G_, int c_) { nM = M / BM; nN = N / BM; nwg = nM * nN; G = G_; c = c_; }
    __host__ __device__ bool next(int i, Unit& u) const {
        const long L = (long)i * G + c; if (L >= nwg) return false;
        int wgid = (int)L; { const int q = nwg / NXCD, r = nwg % NXCD, xcd = wgid % NXCD, off = wgid / NXCD; wgid = (xcd < r ? xcd * (q + 1) : r * (q + 1) + (xcd - r) * q) + off; }
        const int nig = WGM * nN, gid = wgid / nig, fm = gid * WGM, gsz = (nM - fm) < WGM ? (nM - fm) : WGM;
        u.pm = fm + ((wgid % nig) % gsz); u.pn = (wgid % nig) / gsz; return true;
    }
    __device__ __forceinline__ void a_ready(const Unit&) const {}
    __device__ __forceinline__ void done(const Unit&) const {}
};
__device__ __forceinline__ unsigned cvt_pk_bf16(float lo, float hi) { unsigned r; asm volatile("v_cvt_pk_bf16_f32 %0, %1, %2" : "=v"(r) : "v"(lo), "v"(hi)); return r; }
template <class Epi, class Sched, bool ALIGN_EPI = false, bool SP2 = false>
__device__ __forceinline__ void gemm_phase(PG8_LAS unsigned char* lds, const Gemm g, const Sched& S, const Epi& E) {
    int tid_l = threadIdx.x; asm volatile("" : "+v"(tid_l)); const int tid = tid_l, wid = __builtin_amdgcn_readfirstlane(tid >> 6), lane = tid & 63, wr = wid >> 2, wc = wid & 3, fr = lane & 15, fq = lane >> 4;
    const int K = g.K, nt = K / BK;
    unsigned voffA[2], voffB[2];
#pragma unroll
    for (int i = 0; i < 2; ++i) { int R, C; stage_rc(tid * 16 + i * 8192, R, C); const int Rb = Epi::PERM ? ((R & ~31) + perm32(R & 31)) : R;
        voffA[i] = (unsigned)(R * K + C) * 2u; voffB[i] = (unsigned)(Rb * K + C) * 2u; }
    const size_t kstep = (size_t)(BK * 2);
    const size_t hstep = (size_t)HALF * K * 2;
    const size_t tstep = 2 * hstep;
    const unsigned ldsw = (unsigned)wid * 1024u;
    const int aoff = lds_byte(wr * 64 + fr, fq * 8), boff = lds_byte(wc * 32 + fr, fq * 8);
#define PG8_SA(b, h) (((b) * 2 + (h)) * HTB)
#define PG8_SB(b, h) ((4 + (b) * 2 + (h)) * HTB)
#define PG8_STAGE(bufoff, gbase, voff) do { _Pragma("unroll") for (int _i = 0; _i < 2; ++_i) \
        __builtin_amdgcn_global_load_lds((const unsigned*)((const char*)(gbase) + (voff)[_i]), (PG8_LAS unsigned*)(lds + (bufoff) + ldsw + _i * 8192), 16, 0, 0); } while (0)
#define PG8_LDA(dst, b, h) do { _Pragma("unroll") for (int m = 0; m < 4; ++m) _Pragma("unroll") for (int k = 0; k < 2; ++k) dst[m][k] = *(const PG8_LAS bf16x8*)(lds + PG8_SA(b, h) + aoff + m * 2048 + k * 1024); } while (0)
#define PG8_LDB(dst, b, h) do { _Pragma("unroll") for (int n = 0; n < 2; ++n) _Pragma("unroll") for (int k = 0; k < 2; ++k) dst[n][k] = *(const PG8_LAS bf16x8*)(lds + PG8_SB(b, h) + boff + n * 2048 + k * 1024); } while (0)
#define PG8_MMA(ai, bj, At, Bt) do { __builtin_amdgcn_s_setprio(1); _Pragma("unroll") for (int m = 0; m < 4; ++m) _Pragma("unroll") for (int n = 0; n < 2; ++n) _Pragma("unroll") for (int k = 0; k < 2; ++k) \
        acc[ai][bj][m][n] = __builtin_amdgcn_mfma_f32_16x16x32_bf16(Bt[n][k], At[m][k], acc[ai][bj][m][n], 0, 0, 0); __builtin_amdgcn_s_setprio(0); } while (0)
#define PG8_WAIT_V(n) asm volatile("s_waitcnt vmcnt(" #n ")" ::: "memory")
#define PG8_WAIT_L(n) asm volatile("s_waitcnt lgkmcnt(" #n ")" ::: "memory")
#define PG8_BAR __builtin_amdgcn_s_barrier()
#define PG8_SCHED __builtin_amdgcn_sched_barrier(0)
    Unit cur, nxt; int ui = 0;
    if (!S.next(0, cur)) return;
    f32x4 acc[2][2][4][2];
#pragma unroll
    for (int a = 0; a < 2; ++a)
#pragma unroll
        for (int b = 0; b < 2; ++b)
#pragma unroll
            for (int m = 0; m < 4; ++m)
#pragma unroll
                for (int n = 0; n < 2; ++n) acc[a][b][m][n] = (f32x4){0.f, 0.f, 0.f, 0.f};
    bf16x8 At[4][2], B0[2][2], B1[2][2];
    const char* cA = (const char*)g.A + (size_t)cur.pm * tstep; const char* cB = (const char*)g.Bt + (size_t)cur.pn * tstep;
    S.a_ready(cur);
    if constexpr (SP2) {
        PG8_STAGE(PG8_SB(0, 0), cB, voffB); PG8_STAGE(PG8_SB(0, 1), cB + hstep, voffB); PG8_STAGE(PG8_SA(0, 0), cA, voffA); PG8_STAGE(PG8_SA(0, 1), cA + hstep, voffA);
        if (wr == 1) PG8_BAR;
        PG8_WAIT_V(2); PG8_BAR;
        PG8_STAGE(PG8_SB(1, 0), cB + kstep, voffB); PG8_STAGE(PG8_SA(1, 0), cA + kstep, voffA); PG8_STAGE(PG8_SB(1, 1), cB + hstep + kstep, voffB);
        PG8_WAIT_V(6); PG8_BAR;
    } else {
        PG8_STAGE(PG8_SB(0, 0), cB, voffB); PG8_STAGE(PG8_SA(0, 0), cA, voffA); PG8_STAGE(PG8_SB(0, 1), cB + hstep, voffB); PG8_STAGE(PG8_SA(0, 1), cA + hstep, voffA);
        if (wr == 1) PG8_BAR;
        PG8_WAIT_V(4); PG8_BAR;
        PG8_STAGE(PG8_SB(1, 0), cB + kstep, voffB); PG8_STAGE(PG8_SA(1, 0), cA + kstep, voffA); PG8_STAGE(PG8_SB(1, 1), cB + hstep + kstep, voffB);
        PG8_WAIT_V(6); PG8_BAR;
    }
    for (;;) {
        const bool has_next = S.next(ui + 1, nxt);
        const char* nA = has_next ? (const char*)g.A + (size_t)nxt.pm * tstep : cA; const char* nB = has_next ? (const char*)g.Bt + (size_t)nxt.pn * tstep : cB;
        for (int t = 0; t < nt; t += 2) {
            const bool last = (t == nt - 2);
            const char* a1 = cA + (size_t)(t + 1) * kstep;
            const char* a2 = last ? nA : cA + (size_t)(t + 2) * kstep; const char* b2 = last ? nB : cB + (size_t)(t + 2) * kstep;
            const char* a3 = a2 + kstep; const char* b3 = b2 + kstep;
            if (last && has_next) S.a_ready(nxt);
            if constexpr (SP2) {
            PG8_LDB(B0, 0, 0); PG8_LDB(B1, 0, 1); PG8_SCHED; PG8_LDA(At, 0, 0); PG8_STAGE(PG8_SA(1, 1), a1 + hstep, voffA);
            PG8_WAIT_V(8); PG8_WAIT_L(0); PG8_BAR; PG8_MMA(0, 0, At, B0); PG8_MMA(0, 1, At, B1); PG8_BAR; PG8_SCHED;
            PG8_LDA(At, 0, 1); PG8_STAGE(PG8_SB(0, 0), b2, voffB); PG8_STAGE(PG8_SB(0, 1), b2 + hstep, voffB); PG8_STAGE(PG8_SA(0, 0), a2, voffA);
            PG8_WAIT_V(8); PG8_WAIT_L(0); PG8_BAR; PG8_MMA(1, 0, At, B0); PG8_MMA(1, 1, At, B1); PG8_BAR; PG8_SCHED;
            PG8_LDB(B0, 1, 0); PG8_LDB(B1, 1, 1); PG8_SCHED; PG8_LDA(At, 1, 0); PG8_STAGE(PG8_SA(0, 1), a2 + hstep, voffA);
            PG8_WAIT_V(8); PG8_WAIT_L(0); PG8_BAR; PG8_MMA(0, 0, At, B0); PG8_MMA(0, 1, At, B1); PG8_BAR; PG8_SCHED;
            PG8_LDA(At, 1, 1); PG8_STAGE(PG8_SB(1, 0), b3, voffB); PG8_STAGE(PG8_SB(1, 1), b3 + hstep, voffB); PG8_STAGE(PG8_SA(1, 0), a3, voffA);
            PG8_WAIT_V(8); PG8_WAIT_L(0); PG8_BAR; PG8_MMA(1, 0, At, B0); PG8_MMA(1, 1, At, B1); PG8_BAR; PG8_SCHED;
            } else {
            PG8_LDB(B0, 0, 0); PG8_SCHED; PG8_LDA(At, 0, 0); PG8_STAGE(PG8_SA(1, 1), a1 + hstep, voffA);
            PG8_WAIT_L(8); PG8_BAR; PG8_WAIT_L(0); PG8_MMA(0, 0, At, B0); PG8_BAR; PG8_SCHED;
            PG8_LDB(B1, 0, 1); PG8_STAGE(PG8_SB(0, 0), b2, voffB);
            PG8_BAR; PG8_WAIT_L(0); PG8_MMA(0, 1, At, B1); PG8_BAR;
            PG8_LDA(At, 0, 1); PG8_STAGE(PG8_SA(0, 0), a2, voffA);
            PG8_BAR; PG8_WAIT_L(0); PG8_MMA(1, 0, At, B0); PG8_BAR; PG8_SCHED;
            PG8_STAGE(PG8_SB(0, 1), b2 + hstep, voffB);
            PG8_WAIT_V(6); PG8_BAR; PG8_MMA(1, 1, At, B1); PG8_BAR;
            PG8_LDB(B0, 1, 0); PG8_SCHED; PG8_LDA(At, 1, 0); PG8_STAGE(PG8_SA(0, 1), a2 + hstep, voffA);
            PG8_WAIT_L(8); PG8_BAR; PG8_WAIT_L(0); PG8_MMA(0, 0, At, B0); PG8_BAR; PG8_SCHED;
            PG8_LDB(B1, 1, 1); PG8_STAGE(PG8_SB(1, 0), b3, voffB);
            PG8_BAR; PG8_WAIT_L(0); PG8_MMA(0, 1, At, B1); PG8_BAR;
            PG8_LDA(At, 1, 1); PG8_STAGE(PG8_SA(1, 0), a3, voffA);
            PG8_BAR; PG8_WAIT_L(0); PG8_MMA(1, 0, At, B0); PG8_BAR; PG8_SCHED;
            PG8_STAGE(PG8_SB(1, 1), b3 + hstep, voffB);
            PG8_WAIT_V(6); PG8_BAR; PG8_MMA(1, 1, At, B1); PG8_BAR;
            }
        }
        if constexpr (ALIGN_EPI) { if (wr == 0) PG8_BAR; }
        if constexpr (!Epi::AFTER_DRAIN) { E(acc, cur, wr, wc, fr, fq); S.done(cur); }
        if (!has_next) break;
#pragma unroll
        for (int a = 0; a < 2; ++a)
#pragma unroll
            for (int b = 0; b < 2; ++b)
#pragma unroll
                for (int m = 0; m < 4; ++m)
#pragma unroll
                    for (int n = 0; n < 2; ++n) acc[a][b][m][n] = (f32x4){0.f, 0.f, 0.f, 0.f};
        cur = nxt; cA = nA; cB = nB; ++ui;
        if constexpr (ALIGN_EPI) { if (wr == 1) PG8_BAR; }
    }
    PG8_WAIT_V(0);
    if constexpr (!ALIGN_EPI) { if (wr == 0) PG8_BAR; }
    PG8_BAR;
    if constexpr (Epi::AFTER_DRAIN) { E.fused(acc, cur, wr, wc, fr, fq, lds, wid, lane); S.done(cur); }
#undef PG8_SA
#undef PG8_SB
#undef PG8_STAGE
#undef PG8_LDA
#undef PG8_LDB
#undef PG8_MMA
#undef PG8_WAIT_V
#undef PG8_WAIT_L
#undef PG8_BAR
#undef PG8_SCHED
}
}

#define GAS __attribute__((address_space(1)))
#define LAS __attribute__((address_space(3)))
typedef unsigned short bf16;
typedef unsigned v4u __attribute__((ext_vector_type(4)));
typedef unsigned v2u __attribute__((ext_vector_type(2)));
typedef float f32x4 __attribute__((ext_vector_type(4)));
typedef short bf16x8 __attribute__((ext_vector_type(8)));
using pg8::cvt_pk_bf16;

constexpr int DM = 2048, NBATCH = 2, SEQ = 16384, NMETA = 16;
constexpr int NSEG = 4, TSEG = SEQ / NSEG, RS = NBATCH * TSEG, RSB = RS + 256;
constexpr int DINNER = 4096, NHEAD = 64, NGRP = 8, NST = 128, DXBC = 6144, DFF = 5504, NUP = 2 * DFF;
constexpr int NPROJ = 20480, NWIN = 20544;
constexpr int OFF_SCB = 0, OFF_SCC = 2048, OFF_SCH = 4096, OFF_Z = 6144, OFF_XBC = 10240, OFF_GATE = 16384, OFF_DT = 20480;
constexpr float EPS = 1e-6f;
constexpr int NTHREADS = 512, LDS_STAGE = 131072, LDS_XCH = LDS_STAGE + 256, LDS_BYTES = LDS_XCH + 4096;

constexpr size_t al256(size_t x) { return (x + 255) & ~(size_t)255; }
constexpr size_t WS_WIN = 0;
constexpr size_t WS_WA = WS_WIN + (size_t)NWIN * DM * 2;
constexpr size_t WS_WM = WS_WA + (size_t)DM * DM * 2;
constexpr size_t WS_WO = WS_WM + (size_t)DM * DINNER * 2;
constexpr size_t WS_WUP = WS_WO + (size_t)DM * DM * 2;
constexpr size_t WS_WDN = WS_WUP + (size_t)NUP * DM * 2;
constexpr size_t WS_XB = WS_WDN + (size_t)DM * DFF * 2;
constexpr size_t WS_RSTD1 = WS_XB + (size_t)NSEG * RSB * DM * 2;
constexpr size_t WS_PROJ = al256(WS_RSTD1 + (size_t)NSEG * RSB * 4);
constexpr size_t WS_UP = WS_PROJ;
constexpr size_t WS_H1 = WS_UP + (size_t)RSB * NUP * 2;
constexpr size_t WS_YA = WS_PROJ + (size_t)RSB * NPROJ * 2;
constexpr size_t WS_XCONV = WS_YA + (size_t)RSB * DM * 2;
constexpr size_t WS_ACT = WS_XCONV;
constexpr size_t WS_DT = WS_XCONV + (size_t)RSB * DXBC * 2;
constexpr size_t WS_YPRE = WS_DT + (size_t)RSB * 64 * 4;
constexpr size_t WS_TA = WS_YPRE + (size_t)RSB * DINNER * 2;
constexpr size_t WS_MIX = WS_TA + (size_t)RSB * DM * 4;
constexpr size_t WS_SSQ2 = WS_MIX + (size_t)RSB * DM * 2;
constexpr size_t WS_SSQ3 = WS_SSQ2 + (size_t)RSB * 32 * 4;
constexpr size_t WS_STATE = WS_SSQ3 + (size_t)NSEG * RS * 32 * 4;
constexpr size_t WS_CPROJ = WS_STATE + (size_t)2 * 2 * 64 * 64 * 128 * 4;
constexpr size_t WS_CUP = al256(WS_CPROJ + (size_t)2 * 2 * 3 * NPROJ * 2);
constexpr size_t WS_SSQM = al256(WS_CUP + (size_t)2 * 2 * 2 * NUP * 2);
constexpr size_t WS_ACUM = WS_SSQM + 16 * 128 * 4;
constexpr size_t WS_EU = WS_ACUM + (size_t)RSB * 64 * 4;
constexpr size_t WS_EV = WS_EU + (size_t)2 * 32 * 4 * DFF * 4;
constexpr size_t WS_UMETA = WS_EV + (size_t)32 * 2 * DFF * 4;
constexpr size_t WS_H1B = al256(WS_UMETA + (size_t)2 * DFF * 4);
constexpr size_t WS_BAR = al256(WS_H1B + (size_t)RSB * DM * 2);
constexpr size_t WS_END = WS_BAR + 16384;
static_assert(WS_END <= (size_t)1073741824, "workspace map must fit 1 GiB");

struct Params {
    const float *x, *meta, *norm1_g, *w_in, *b_gate, *sc_conv_w, *mb_conv_w, *mb_conv_b, *dt_bias, *a_log, *d_skip, *mb_norm_g, *w_a, *w_m, *w_o, *norm2_g, *w_up, *ffn_conv_w, *ffn_conv_b, *w_down, *normf_g;
    float* out; unsigned char* ws;
};

#define LDS_WAIT() asm volatile("s_waitcnt lgkmcnt(0)" ::: "memory")
typedef GAS unsigned char* gws_t;
__device__ __forceinline__ gws_t launder_s(const void* p0) { unsigned char* p = (unsigned char*)p0; asm volatile("" : "+s"(p)); return (gws_t)p; }
__device__ __forceinline__ int launder_v(int v) { asm volatile("" : "+v"(v)); return v; }
__device__ __forceinline__ int grid_x() { int g = (int)gridDim.x; asm volatile("" : "+s"(g)); return g; }
__device__ __forceinline__ unsigned f2bf(float f) { return (unsigned)__builtin_bit_cast(unsigned short, (__bf16)f); }
__device__ __forceinline__ unsigned pk2(float lo, float hi) { return cvt_pk_bf16(lo, hi); }
__device__ __forceinline__ bf16 f2bfh(float f) { return (bf16)(cvt_pk_bf16(f, f) & 0xffffu); }
__device__ __forceinline__ float bf2f(unsigned short b) { return __builtin_bit_cast(float, (unsigned)b << 16); }
__device__ __forceinline__ float bflo(unsigned w) { return __builtin_bit_cast(float, w << 16); }
__device__ __forceinline__ float bfhi(unsigned w) { return __builtin_bit_cast(float, w & 0xffff0000u); }
__device__ __forceinline__ void unpack8(const v4u v, float (&f)[8]) { f[0] = bflo(v.x); f[1] = bfhi(v.x); f[2] = bflo(v.y); f[3] = bfhi(v.y); f[4] = bflo(v.z); f[5] = bfhi(v.z); f[6] = bflo(v.w); f[7] = bfhi(v.w); }
__device__ __forceinline__ v4u pack8(const float (&f)[8]) { v4u o; o.x = cvt_pk_bf16(f[0], f[1]); o.y = cvt_pk_bf16(f[2], f[3]); o.z = cvt_pk_bf16(f[4], f[5]); o.w = cvt_pk_bf16(f[6], f[7]); return o; }
__device__ __forceinline__ float sigmoidf_(float x) { return __builtin_amdgcn_rcpf(1.f + __expf(-x)); }
__device__ __forceinline__ float siluf_(float x) { return x * __builtin_amdgcn_rcpf(1.f + __expf(-x)); }
__device__ __forceinline__ float wave_sum(float v) {
#pragma unroll
    for (int o = 1; o < 64; o <<= 1) v += __shfl_xor(v, o);
    return v;
}

struct Epi1 {
    static constexpr bool PERM = true, AFTER_DRAIN = false;
    GAS bf16* O; const GAS float* rstd;
    __device__ __forceinline__ void operator()(const f32x4 (&acc)[2][2][4][2], const pg8::Unit& u, int wr, int wc, int fr, int fq) const {
        const int row0 = u.pm * 256 + wr * 64 + fr, col0 = u.pn * 256 + wc * 32 + 8 * fq;
        float rs[8];
#pragma unroll
        for (int i = 0; i < 8; ++i) rs[i] = rstd[row0 + (i >> 2) * 128 + (i & 3) * 16];
#pragma unroll
        for (int ai = 0; ai < 2; ++ai)
#pragma unroll
            for (int m = 0; m < 4; ++m) { const int row = row0 + ai * 128 + m * 16; const float r = rs[ai * 4 + m]; GAS bf16* rowp = O + (size_t)row * NPROJ + col0;
#pragma unroll
                for (int bj = 0; bj < 2; ++bj) { const f32x4 v0 = acc[ai][bj][m][0] * r, v1 = acc[ai][bj][m][1] * r; v4u w;
                    w.x = cvt_pk_bf16(v0[0], v0[1]); w.y = cvt_pk_bf16(v0[2], v0[3]); w.z = cvt_pk_bf16(v1[0], v1[1]); w.w = cvt_pk_bf16(v1[2], v1[3]);
                    *(GAS v4u*)(rowp + bj * 128) = w; } }
    }
};
template <int WHICH> struct EpiGate {
    static constexpr bool PERM = true, AFTER_DRAIN = false;
    const GAS bf16* proj; const float* bgate; GAS bf16* ta; GAS bf16* mix;
    __device__ __forceinline__ void operator()(const f32x4 (&acc)[2][2][4][2], const pg8::Unit& u, int wr, int wc, int fr, int fq) const {
        const int row0 = u.pm * 256 + wr * 64 + fr, col0 = u.pn * 256 + wc * 32 + 8 * fq;
#pragma unroll
        for (int bj = 0; bj < 2; ++bj) { const int col = col0 + bj * 128;
            const f32x4 b0 = *(const GAS f32x4*)(bgate + WHICH * DM + col), b1 = *(const GAS f32x4*)(bgate + WHICH * DM + col + 4);
#pragma unroll
            for (int aim = 0; aim < 4; ++aim) { const int ai = aim >> 1, mb = (aim & 1) * 2;
                v4u gv[4], tv[4];
#pragma unroll
                for (int m = mb; m < mb + 2; ++m) { const int row = row0 + ai * 128 + m * 16;
                    gv[m] = __builtin_nontemporal_load((const GAS v4u*)(proj + (size_t)row * NPROJ + OFF_GATE + WHICH * DM + col));
                    if (WHICH == 1) tv[m] = *(const GAS v4u*)(ta + (size_t)row * DM + col); }
#pragma unroll
                for (int m = mb; m < mb + 2; ++m) { const int row = row0 + ai * 128 + m * 16; float g[8]; unpack8(gv[m], g);
                    const f32x4 a0 = acc[ai][bj][m][0], a1 = acc[ai][bj][m][1]; float r[8];
#pragma unroll
                    for (int e = 0; e < 4; ++e) { r[e] = sigmoidf_(g[e] + b0[e]) * a0[e]; r[4 + e] = sigmoidf_(g[4 + e] + b1[e]) * a1[e]; }
                    if (WHICH == 0) *(GAS v4u*)(ta + (size_t)row * DM + col) = pack8(r);
                    else { float tf[8]; unpack8(tv[m], tf);
#pragma unroll
                        for (int e = 0; e < 8; ++e) r[e] += tf[e];
                        *(GAS v4u*)(mix + (size_t)row * DM + col) = pack8(r); } }
            }
        }
    }
};
struct Epi4 {
    static constexpr bool PERM = true, AFTER_DRAIN = false;
    const float* x; const float* meta; GAS bf16* h1b; GAS float* ssq; int seg;
    __device__ __forceinline__ void operator()(const f32x4 (&acc)[2][2][4][2], const pg8::Unit& u, int wr, int wc, int fr, int fq) const {
        const int row0 = u.pm * 256 + wr * 64 + fr, col0 = u.pn * 256 + wc * 32 + 8 * fq;
#pragma unroll
        for (int aim = 0; aim < 4; ++aim) { const int ai = aim >> 1, mb = (aim & 1) * 2;
            f32x4 hx[4][2][2];
#pragma unroll
            for (int m = mb; m < mb + 2; ++m) { const int row = row0 + ai * 128 + m * 16;
                const GAS float* hp = (const GAS float*)x + ((size_t)(row / TSEG) * SEQ + (size_t)seg * TSEG + (row % TSEG)) * DM + col0;
#pragma unroll
                for (int bj = 0; bj < 2; ++bj) { hx[m][bj][0] = __builtin_nontemporal_load((const GAS f32x4*)(hp + bj * 128)); hx[m][bj][1] = __builtin_nontemporal_load((const GAS f32x4*)(hp + bj * 128 + 4)); } }
#pragma unroll
            for (int m = mb; m < mb + 2; ++m) { const int row = row0 + ai * 128 + m * 16;
                float s = 0.f;
#pragma unroll
                for (int bj = 0; bj < 2; ++bj) { const int col = col0 + bj * 128; const f32x4 v0 = acc[ai][bj][m][0] + hx[m][bj][0], v1 = acc[ai][bj][m][1] + hx[m][bj][1];
                    v4u w; w.x = cvt_pk_bf16(v0[0], v0[1]); w.y = cvt_pk_bf16(v0[2], v0[3]); w.z = cvt_pk_bf16(v1[0], v1[1]); w.w = cvt_pk_bf16(v1[2], v1[3]);
                    *(GAS v4u*)(h1b + (size_t)row * DM + col) = w;
                    s += (v0[0] * v0[0] + v0[1] * v0[1]) + (v0[2] * v0[2] + v0[3] * v0[3]) + (v1[0] * v1[0] + v1[1] * v1[1]) + (v1[2] * v1[2] + v1[3] * v1[3]); }
                s += __shfl_xor(s, 16); s += __shfl_xor(s, 32);
                if (fq == 0) ssq[(size_t)row * 32 + u.pn * 4 + wc] = s; } }
    }
};
template <int N> __device__ __forceinline__ float row_up(float prev, float cur) {
    const int pr = __builtin_amdgcn_update_dpp(0, __builtin_bit_cast(int, prev), 0x120 + N, 0xf, 0xf, false);
    const int r = __builtin_amdgcn_update_dpp(pr, __builtin_bit_cast(int, cur), 0x110 + N, 0xf, 0xf, false);
    return __builtin_bit_cast(float, r);
}
struct Epi5 {
    static constexpr bool PERM = true, AFTER_DRAIN = false;
    GAS bf16* act; const GAS float* ssq; const float* cw; const float* cb; GAS float* eu; GAS float* ev; LAS float* xch;
    __device__ __forceinline__ void operator()(const f32x4 (&acc)[2][2][4][2], const pg8::Unit& u, int wr, int wc, int fr, int fq) const {
        const int row0 = u.pm * 256 + wr * 64 + fr, ch0 = u.pn * 128 + wc * 32 + 8 * fq, lc = wc * 32 + 8 * fq;
        float rs[8];
#pragma unroll
        for (int i = 0; i < 8; ++i) { const int row = row0 + (i >> 2) * 128 + (i & 3) * 16;
            const f32x4 p0 = *(const GAS f32x4*)(ssq + (size_t)row * 32 + fq * 8), p1 = *(const GAS f32x4*)(ssq + (size_t)row * 32 + fq * 8 + 4);
            rs[i] = (p0[0] + p0[1]) + (p0[2] + p0[3]) + (p1[0] + p1[1]) + (p1[2] + p1[3]); }
        float w0[8], w1[8], w2[8], bb[8];
#pragma unroll
        for (int e = 0; e < 8; ++e) { w0[e] = cw[0 * DFF + ch0 + e]; w1[e] = cw[1 * DFF + ch0 + e]; w2[e] = cw[2 * DFF + ch0 + e]; bb[e] = cb[ch0 + e]; }
#pragma unroll
        for (int i = 0; i < 8; ++i) { float s = rs[i]; s += __shfl_xor(s, 16); s += __shfl_xor(s, 32); rs[i] = rsqrtf(s * (1.f / DM) + EPS); }
        float us[2][4][8];
#pragma unroll
        for (int ai = 0; ai < 2; ++ai)
#pragma unroll
            for (int m = 0; m < 4; ++m) { const float r = rs[ai * 4 + m];
#pragma unroll
                for (int e = 0; e < 4; ++e) { us[ai][m][e] = acc[ai][0][m][0][e] * r; us[ai][m][4 + e] = acc[ai][0][m][1][e] * r; } }
        if (fr >= 14) {
#pragma unroll
            for (int ai = 0; ai < 2; ++ai) { LAS float* xp = xch + ((2 * ai + wr) * 2 + (fr - 14)) * 128 + lc;
                *(LAS f32x4*)xp = (f32x4){us[ai][3][0], us[ai][3][1], us[ai][3][2], us[ai][3][3]}; *(LAS f32x4*)(xp + 4) = (f32x4){us[ai][3][4], us[ai][3][5], us[ai][3][6], us[ai][3][7]}; } }
        asm volatile("s_waitcnt lgkmcnt(0)" ::: "memory"); __builtin_amdgcn_s_barrier(); asm volatile("" ::: "memory");
        const int pb = (u.pm & 31);
        GAS float* eup = eu + (size_t)pb * 4 * DFF + ch0; GAS float* evp = ev + (size_t)pb * 2 * DFF + ch0;
#pragma unroll
        for (int ai = 0; ai < 2; ++ai) {
            float prev[8];
            { const int gi = 2 * ai + wr;
              if (gi >= 1 && fr >= 14) { const LAS float* xp = xch + ((gi - 1) * 2 + (fr - 14)) * 128 + lc; const f32x4 a = *(const LAS f32x4*)xp, c = *(const LAS f32x4*)(xp + 4);
#pragma unroll
                  for (int e = 0; e < 4; ++e) { prev[e] = a[e]; prev[4 + e] = c[e]; } }
              else {
#pragma unroll
                  for (int e = 0; e < 8; ++e) prev[e] = 0.f; } }
#pragma unroll
            for (int m = 0; m < 4; ++m) { const int row = row0 + ai * 128 + m * 16; const float r = rs[ai * 4 + m]; float y[8];
#pragma unroll
                for (int e = 0; e < 8; ++e) { const float cur = us[ai][m][e], pv = (m == 0) ? prev[e] : us[ai][m - 1][e];
                    const float um1 = row_up<1>(pv, cur), um2 = row_up<2>(pv, cur);
                    const float vv = ((e < 4) ? acc[ai][1][m][0][e & 3] : acc[ai][1][m][1][e & 3]) * r;
                    y[e] = siluf_(bb[e] + w0[e] * um2 + w1[e] * um1 + w2[e] * cur) * vv; }
                *(GAS v4u*)(act + (size_t)row * DFF + ch0) = pack8(y);
                if (ai == 0 && m == 0 && wr == 0 && fr < 2) {
                    GAS float* p = eup + (size_t)(2 + fr) * DFF; GAS float* q = evp + (size_t)fr * DFF;
#pragma unroll
                    for (int e = 0; e < 8; ++e) { p[e] = us[0][0][e]; q[e] = ((e < 4) ? acc[0][1][0][0][e & 3] : acc[0][1][0][1][e & 3]) * r; } }
                if (ai == 1 && m == 3 && wr == 1 && fr >= 14) {
                    GAS float* p = eup + (size_t)(fr - 14) * DFF;
#pragma unroll
                    for (int e = 0; e < 8; ++e) p[e] = us[1][3][e]; } }
        }
    }
};
struct Epi6 {
    static constexpr bool PERM = true, AFTER_DRAIN = false;
    const GAS bf16* h1; float* out; GAS float* ssq; int seg;
    __device__ __forceinline__ void operator()(const f32x4 (&acc)[2][2][4][2], const pg8::Unit& u, int wr, int wc, int fr, int fq) const {
        const int row0 = u.pm * 256 + wr * 64 + fr, col0 = u.pn * 256 + wc * 32 + 8 * fq;
#pragma unroll
        for (int aim = 0; aim < 4; ++aim) { const int ai = aim >> 1, mb = (aim & 1) * 2;
            v4u hr[4][2];
#pragma unroll
            for (int m = mb; m < mb + 2; ++m) { const GAS bf16* hp = h1 + (size_t)(row0 + ai * 128 + m * 16) * DM + col0;
#pragma unroll
                for (int bj = 0; bj < 2; ++bj) hr[m][bj] = *(const GAS v4u*)(hp + bj * 128); }
#pragma unroll
            for (int m = mb; m < mb + 2; ++m) { const int row = row0 + ai * 128 + m * 16;
                GAS bf16* op = (GAS bf16*)((GAS float*)out + ((size_t)(row / TSEG) * SEQ + (size_t)seg * TSEG + (row % TSEG)) * DM);
                float s = 0.f;
#pragma unroll
                for (int bj = 0; bj < 2; ++bj) { const int col = col0 + bj * 128; float hf[8]; unpack8(hr[m][bj], hf);
                    const f32x4 v0 = acc[ai][bj][m][0] + (f32x4){hf[0], hf[1], hf[2], hf[3]}, v1 = acc[ai][bj][m][1] + (f32x4){hf[4], hf[5], hf[6], hf[7]};
                    { v4u w; w.x = cvt_pk_bf16(v0[0], v0[1]); w.y = cvt_pk_bf16(v0[2], v0[3]); w.z = cvt_pk_bf16(v1[0], v1[1]); w.w = cvt_pk_bf16(v1[2], v1[3]); __builtin_nontemporal_store(w, (GAS v4u*)(op + col)); }
                    s += (v0[0] * v0[0] + v0[1] * v0[1]) + (v0[2] * v0[2] + v0[3] * v0[3]) + (v1[0] * v1[0] + v1[1] * v1[1]) + (v1[2] * v1[2] + v1[3] * v1[3]); }
                s += __shfl_xor(s, 16); s += __shfl_xor(s, 32);
                if (fq == 0) ssq[((size_t)seg * RS + row) * 32 + u.pn * 4 + wc] = s; } }
    }
};

template <class Epi> __device__ __forceinline__ void run_gemm(unsigned char* smem, const GAS bf16* A, const GAS bf16* Bt, int M, int N, int K, const Epi& E) {
    pg8::Gemm g; g.A = (const bf16*)A; g.Bt = (const bf16*)Bt; g.M = M; g.N = N; g.K = K;
    pg8::StaticOrder S; S.init(M, N, grid_x(), (int)blockIdx.x);
    pg8::gemm_phase<Epi, pg8::StaticOrder, true, true>((PG8_LAS unsigned char*)smem, g, S, E);
}

__device__ __forceinline__ void p0_transpose_item(const float* W, int Nsrc, int K, const float* gain, GAS bf16* WT, int k0, int n0d, int n0s, float* scr, int lane) {
    float v[32];
    const float* wp = W + (size_t)(k0 + (lane >> 5)) * Nsrc + n0s + (lane & 31);
#pragma unroll
    for (int i = 0; i < 32; ++i) v[i] = __builtin_nontemporal_load((const GAS float*)wp + (size_t)(2 * i) * Nsrc);
    if (gain) {
#pragma unroll
        for (int i = 0; i < 32; ++i) v[i] *= gain[k0 + 2 * i + (lane >> 5)]; }
#pragma unroll
    for (int i = 0; i < 32; ++i) scr[(2 * i + (lane >> 5)) * 33 + (lane & 31)] = v[i];
    LDS_WAIT(); asm volatile("" ::: "memory");
    const int c = lane & 7;
#pragma unroll
    for (int j = 0; j < 4; ++j) { const int n = (lane >> 3) + 8 * j; const float* s = scr + (8 * c) * 33 + n;
        v4u o; o.x = pk2(s[0 * 33], s[1 * 33]); o.y = pk2(s[2 * 33], s[3 * 33]); o.z = pk2(s[4 * 33], s[5 * 33]); o.w = pk2(s[6 * 33], s[7 * 33]);
        *(GAS v4u*)(WT + (size_t)(n0d + n) * K + k0 + 8 * c) = o; }
    LDS_WAIT(); asm volatile("" ::: "memory");
}
__device__ __forceinline__ void phase_prep(const Params& P, unsigned char* smem) {
    const int tidl = launder_v(threadIdx.x); const int lane = tidl & 63, wave = tidl >> 6;
    const int gw = blockIdx.x * 8 + wave, NGW = grid_x() * 8;
    float* scr = (float*)(smem + wave * 8448);
    gws_t ws = launder_s(P.ws);
    constexpr int I_IN = (DM / 64) * (NWIN / 32), I_A = (DM / 64) * (DM / 32), I_M = (DINNER / 64) * (DM / 32), I_O = I_A, I_UP = (DM / 64) * (NUP / 32), I_DN = (DFF / 64) * (DM / 32);
    constexpr int NITEMS = I_IN + I_A + I_M + I_O + I_UP + I_DN;
    for (int it = gw; it < NITEMS; it += NGW) {
        int r = it + I_IN; if (r >= NITEMS) r -= NITEMS;
        if (r < I_IN) { const int nblk = NWIN / 32, kb = r / nblk, nb = r % nblk, n0d = nb * 32;
            int n0s; if (n0d < 16384) n0s = n0d; else if (n0d < 20480) n0s = n0d + 64; else n0s = n0d - 4096;
            p0_transpose_item(P.w_in, 20544, DM, P.norm1_g, (GAS bf16*)(ws + WS_WIN), kb * 64, n0d, n0s, scr, lane); continue; } r -= I_IN;
        if (r < I_A) { const int nblk = DM / 32, kb = r / nblk, nb = r % nblk; p0_transpose_item(P.w_a, DM, DM, nullptr, (GAS bf16*)(ws + WS_WA), kb * 64, nb * 32, nb * 32, scr, lane); continue; } r -= I_A;
        if (r < I_M) { const int nblk = DM / 32, kb = r / nblk, nb = r % nblk; p0_transpose_item(P.w_m, DM, DINNER, P.mb_norm_g, (GAS bf16*)(ws + WS_WM), kb * 64, nb * 32, nb * 32, scr, lane); continue; } r -= I_M;
        if (r < I_O) { const int nblk = DM / 32, kb = r / nblk, nb = r % nblk; p0_transpose_item(P.w_o, DM, DM, nullptr, (GAS bf16*)(ws + WS_WO), kb * 64, nb * 32, nb * 32, scr, lane); continue; } r -= I_O;
        if (r < I_UP) { const int nblk = NUP / 32, kb = r / nblk, nb = r % nblk, n0d = nb * 32, t = n0d >> 8, j = n0d & 255;
            const int n0s = (j < 128) ? 128 * t + j : DFF + 128 * t + (j - 128);
            p0_transpose_item(P.w_up, NUP, DM, P.norm2_g, (GAS bf16*)(ws + WS_WUP), kb * 64, n0d, n0s, scr, lane); continue; } r -= I_UP;
        { const int nblk = DM / 32, kb = r / nblk, nb = r % nblk; p0_transpose_item(P.w_down, DM, DFF, nullptr, (GAS bf16*)(ws + WS_WDN), kb * 64, nb * 32, nb * 32, scr, lane); }
    }
    GAS bf16* xb = (GAS bf16*)(ws + WS_XB); GAS float* rstd1 = (GAS float*)(ws + WS_RSTD1);
    for (int rid = gw; rid < NSEG * RSB; rid += NGW) {
        const int s = rid / RSB, lr = rid % RSB; const float* src = nullptr;
        if (lr < RS) src = P.x + ((size_t)(lr / TSEG) * SEQ + (size_t)s * TSEG + (lr % TSEG)) * DM;
        else if (s == 0) { if (lr >= RS + 48 && lr < RS + 64) src = P.meta + (size_t)(lr - RS - 48) * DM; }
        else continue;
        GAS v2u* o8 = (GAS v2u*)(xb + (size_t)rid * DM) + lane; float ss = 0.f;
        if (src) { const f32x4* xr = (const f32x4*)src + lane;
#pragma unroll
            for (int j = 0; j < 8; ++j) { const f32x4 v = __builtin_nontemporal_load((const GAS f32x4*)xr + 64 * j); ss += (v[0] * v[0] + v[1] * v[1]) + (v[2] * v[2] + v[3] * v[3]); v2u o; o.x = cvt_pk_bf16(v[0], v[1]); o.y = cvt_pk_bf16(v[2], v[3]); o8[64 * j] = o; } }
        else {
#pragma unroll
            for (int j = 0; j < 8; ++j) { v2u o; o.x = 0u; o.y = 0u; o8[64 * j] = o; } }
        ss = wave_sum(ss);
        if (lane == 0) rstd1[rid] = rsqrtf(ss * (1.f / DM) + EPS);
    }
}

__device__ __forceinline__ void phase_conv(const Params& P, int seg) {
    gws_t ws = launder_s(P.ws);
    const GAS bf16* proj = (const GAS bf16*)(ws + WS_PROJ); GAS bf16* ya = (GAS bf16*)(ws + WS_YA); GAS bf16* xconv = (GAS bf16*)(ws + WS_XCONV);
    const GAS bf16* carry_rd = (const GAS bf16*)(ws + WS_CPROJ) + (size_t)(seg & 1) * (2 * 3 * NPROJ);
    GAS bf16* carry_wr = (GAS bf16*)(ws + WS_CPROJ) + (size_t)((seg + 1) & 1) * (2 * 3 * NPROJ);
    const int nruns = RS / 16 + (seg == 0 ? 1 : 0);
    if (__builtin_amdgcn_readfirstlane(threadIdx.x) >= 256) __builtin_amdgcn_s_setprio(1);
    const int gtid = blockIdx.x * NTHREADS + launder_v(threadIdx.x), NT = grid_x() * NTHREADS;
    auto prow = [&](int lr, int k) -> const GAS bf16* {
        if (lr >= RS) return proj + (size_t)(lr - k) * NPROJ;
        const int tt = lr & (TSEG - 1);
        if (tt >= k) return proj + (size_t)(lr - k) * NPROJ;
        if (seg == 0) return proj + (size_t)(RS + 64 + tt - k) * NPROJ;
        return carry_rd + (size_t)((lr / TSEG) * 3 + 3 + tt - k) * NPROJ;
    };
    for (int idx = gtid; idx < nruns * (DXBC / 8); idx += NT) {
        const int r = idx / (DXBC / 8), c = (idx % (DXBC / 8)) * 8, lr0 = (r < RS / 16) ? r * 16 : RS + 48;
        float w0[8], w1[8], w2[8], w3[8], bb[8];
#pragma unroll
        for (int e = 0; e < 8; ++e) { w0[e] = P.mb_conv_w[0 * DXBC + c + e]; w1[e] = P.mb_conv_w[1 * DXBC + c + e]; w2[e] = P.mb_conv_w[2 * DXBC + c + e]; w3[e] = P.mb_conv_w[3 * DXBC + c + e]; bb[e] = P.mb_conv_b[c + e]; }
        float x0[8], x1[8], x2[8], x3[8];
        unpack8(*(const GAS v4u*)(prow(lr0, 3) + OFF_XBC + c), x0); unpack8(*(const GAS v4u*)(prow(lr0, 2) + OFF_XBC + c), x1); unpack8(*(const GAS v4u*)(prow(lr0, 1) + OFF_XBC + c), x2);
#pragma unroll
        for (int hb = 0; hb < 2; ++hb) { v4u raw[8];
#pragma unroll
            for (int i = 0; i < 8; ++i) raw[i] = __builtin_nontemporal_load((const GAS v4u*)(proj + (size_t)(lr0 + hb * 8 + i) * NPROJ + OFF_XBC + c));
#pragma unroll
            for (int i = 0; i < 8; ++i) { unpack8(raw[i], x3); float y[8];
#pragma unroll
                for (int e = 0; e < 8; ++e) { y[e] = siluf_(bb[e] + w0[e] * x0[e] + w1[e] * x1[e] + w2[e] * x2[e] + w3[e] * x3[e]); x0[e] = x1[e]; x1[e] = x2[e]; x2[e] = x3[e]; }
                *(GAS v4u*)(xconv + (size_t)(lr0 + hb * 8 + i) * DXBC + c) = pack8(y); } }
    }
    for (int idx = gtid; idx < nruns * (DM / 8); idx += NT) {
        const int r = idx / (DM / 8), c = (idx % (DM / 8)) * 8, lr0 = (r < RS / 16) ? r * 16 : RS + 48;
        float w0[8], w1[8], w2[8];
#pragma unroll
        for (int e = 0; e < 8; ++e) { w0[e] = P.sc_conv_w[0 * DM + c + e]; w1[e] = P.sc_conv_w[1 * DM + c + e]; w2[e] = P.sc_conv_w[2 * DM + c + e]; }
        float p0[8], p1[8], p2[8], t0[8], t1[8];
        { const GAS bf16* q = prow(lr0, 2); unpack8(*(const GAS v4u*)(q + OFF_SCC + c), t0); unpack8(*(const GAS v4u*)(q + OFF_SCH + c), t1);
#pragma unroll
          for (int e = 0; e < 8; ++e) p0[e] = t0[e] * t1[e]; }
        { const GAS bf16* q = prow(lr0, 1); unpack8(*(const GAS v4u*)(q + OFF_SCC + c), t0); unpack8(*(const GAS v4u*)(q + OFF_SCH + c), t1);
#pragma unroll
          for (int e = 0; e < 8; ++e) p1[e] = t0[e] * t1[e]; }
#pragma unroll
        for (int hb = 0; hb < 4; ++hb) { v4u rc[4], rh[4], rb[4];
#pragma unroll
            for (int i = 0; i < 4; ++i) { const GAS bf16* q = proj + (size_t)(lr0 + hb * 4 + i) * NPROJ; rc[i] = __builtin_nontemporal_load((const GAS v4u*)(q + OFF_SCC + c)); rh[i] = __builtin_nontemporal_load((const GAS v4u*)(q + OFF_SCH + c)); rb[i] = __builtin_nontemporal_load((const GAS v4u*)(q + OFF_SCB + c)); }
#pragma unroll
            for (int i = 0; i < 4; ++i) { float bv[8], y[8]; unpack8(rc[i], t0); unpack8(rh[i], t1); unpack8(rb[i], bv);
#pragma unroll
                for (int e = 0; e < 8; ++e) { p2[e] = t0[e] * t1[e]; y[e] = bv[e] * (w0[e] * p0[e] + w1[e] * p1[e] + w2[e] * p2[e]); p0[e] = p1[e]; p1[e] = p2[e]; }
                *(GAS v4u*)(ya + (size_t)(lr0 + hb * 4 + i) * DM + c) = pack8(y); } }
    }
    if (seg == 0)
        for (int idx = gtid; idx < 48 * (DXBC / 8); idx += NT) { v4u z; z.x = 0u; z.y = 0u; z.z = 0u; z.w = 0u; *(GAS v4u*)(xconv + (size_t)(RS + idx / (DXBC / 8)) * DXBC + (idx % (DXBC / 8)) * 8) = z; }
    { const GAS float* dtv = (const GAS float*)(ws + WS_DT); GAS float* acv = (GAS float*)(ws + WS_ACUM); const int nch = RS / 64 + (seg == 0 ? 1 : 0);
      for (int idx = gtid; idx < nch * 64; idx += NT) { const int c = idx >> 6, hd = idx & 63, r0 = (c < RS / 64) ? c * 64 : RS; const float Ah = -__expf(P.a_log[hd]); float acc = 0.f;
#pragma unroll 16
          for (int i = 0; i < 64; ++i) { acc += dtv[(size_t)(r0 + i) * 64 + hd] * Ah; acv[(size_t)(r0 + i) * 64 + hd] = acc; } } }
    if (seg + 1 < NSEG)
        for (int idx = gtid; idx < 2 * 3 * (NPROJ / 8); idx += NT) { const int c8 = idx % (NPROJ / 8), rk = idx / (NPROJ / 8), b = rk / 3, k = rk % 3;
            *(GAS v4u*)(carry_wr + (size_t)rk * NPROJ + c8 * 8) = *(const GAS v4u*)(proj + (size_t)(b * TSEG + TSEG - 3 + k) * NPROJ + c8 * 8); }
    __builtin_amdgcn_s_setprio(0);
}

constexpr int T_CS = 0, T_BS = T_CS + 64 * 272, T_XD = T_BS + 64 * 272, T_XE = T_XD + 64 * 80, T_XS = T_XE + 64 * 80, T_ZS = T_XS + 64 * 64, T_BUF = T_ZS + 64 * 64;
constexpr int T_ST = 2 * T_BUF, T_STSZ = 32 * 272, T_AC = T_ST + 2 * T_STSZ, T_END = T_AC + 2 * 256;
static_assert(T_END <= LDS_STAGE, "SSD LDS map");
__device__ __forceinline__ f32x4 mfma16(const bf16x8& a, const bf16x8& b, const f32x4& c) { return __builtin_amdgcn_mfma_f32_16x16x32_bf16(a, b, c, 0, 0, 0); }
#define BAR_LDS() do { asm volatile("s_waitcnt lgkmcnt(0)" ::: "memory"); __builtin_amdgcn_s_barrier(); asm volatile("" ::: "memory"); } while (0)
#define TR_ISSUE(dst, addr) asm volatile("ds_read_b64_tr_b16 %0, %1" : "=v"(dst) : "v"(addr) : "memory")
__device__ __forceinline__ bf16x8 mk8(const v2u& lo, const v2u& hi) { v4u t; t.x = lo.x; t.y = lo.y; t.z = hi.x; t.w = hi.y; return __builtin_bit_cast(bf16x8, t); }
__device__ __forceinline__ void phase_ssd(const Params& P, int seg, unsigned char* smem) {
    gws_t ws = launder_s(P.ws);
    const GAS bf16* proj = (const GAS bf16*)(ws + WS_PROJ); const GAS bf16* xconv = (const GAS bf16*)(ws + WS_XCONV); const GAS float* dtv = (const GAS float*)(ws + WS_DT); const GAS float* acv = (const GAS float*)(ws + WS_ACUM);
    GAS bf16* ypre = (GAS bf16*)(ws + WS_YPRE); GAS float* state = (GAS float*)(ws + WS_STATE);
    const int tid = launder_v(threadIdx.x), lane = tid & 63, w = tid >> 6, fr = lane & 15, fq = lane >> 4;
    const unsigned lds0 = (unsigned)(size_t)(LAS unsigned char*)smem;
    bf16* StS = (bf16*)(smem + T_ST); float* acS = (float*)(smem + T_AC);
    const int lt = w >> 1, pt = w & 1, tq = (lane & 15) >> 2, tp = lane & 3;
    if (__builtin_amdgcn_readfirstlane(tid) >= 256) __builtin_amdgcn_s_setprio(1);
    const int gx = grid_x();
    for (int item = blockIdx.x; item < 256; item += gx) {
        const int xcd = item & 7, ix = item >> 3, bg = xcd * 2 + (ix >> 4), b = bg >> 3, g = bg & 7, h = g * 8 + ((ix & 15) >> 1), ph = ix & 1;
        const float Dh = P.d_skip[h];
        const GAS float* stg = state + (size_t)(seg & 1) * (2 * 64 * 64 * 128) + ((size_t)(b * 64 + h) * 64 + ph * 32) * 128;
        GAS float* stw = state + (size_t)((seg + 1) & 1) * (2 * 64 * 64 * 128) + ((size_t)(b * 64 + h) * 64 + ph * 32) * 128;
        f32x4 st[2];
#pragma unroll
        for (int p2 = 0; p2 < 2; ++p2)
#pragma unroll
            for (int j = 0; j < 4; ++j) st[p2][j] = (seg == 0) ? 0.f : stg[(size_t)(p2 * 16 + fq * 4 + j) * 128 + w * 16 + fr];
        __syncthreads();
#pragma unroll
        for (int p2 = 0; p2 < 2; ++p2)
#pragma unroll
            for (int j = 0; j < 4; ++j) StS[(p2 * 16 + fq * 4 + j) * 136 + w * 16 + fr] = (bf16)f2bf(st[p2][j]);
        const int nchunks = TSEG / 64 + (seg == 0 ? 1 : 0);
        struct Pre { v4u Br[2], Cr[2]; v2u Xr, Zr; float dtl, acl, alast, aclane; }; Pre RA, RB;
        auto chunk_row0 = [&](int ci) -> int { return (seg == 0) ? (ci == 0 ? RS : b * TSEG + (ci - 1) * 64) : b * TSEG + ci * 64; };
        auto load_chunk = [&](int ci, Pre& R) { const int row0 = chunk_row0(ci);
#pragma unroll
            for (int i = 0; i < 2; ++i) { const int q = tid + 512 * i, l = q >> 4, c8 = q & 15; const GAS bf16* rp = xconv + (size_t)(row0 + l) * DXBC + g * 128 + c8 * 8;
                R.Br[i] = *(const GAS v4u*)(rp + 4096); R.Cr[i] = *(const GAS v4u*)(rp + 5120); }
            { const int l = tid >> 3, p4 = (tid & 7) * 4; R.Xr = *(const GAS v2u*)(xconv + (size_t)(row0 + l) * DXBC + h * 64 + ph * 32 + p4);
              R.Zr = __builtin_nontemporal_load((const GAS v2u*)(proj + (size_t)(row0 + l) * NPROJ + OFF_Z + h * 64 + ph * 32 + p4));
              R.dtl = dtv[(size_t)(row0 + l) * 64 + h]; R.acl = acv[(size_t)(row0 + l) * 64 + h]; }
            R.alast = acv[(size_t)(row0 + 63) * 64 + h]; R.aclane = acv[(size_t)(row0 + lane) * 64 + h]; };
        load_chunk(0, RA); if (nchunks > 1) load_chunk(1, RB);
        auto step = [&](int ci, Pre& R, const int par) {
            const int row0 = chunk_row0(ci); unsigned char* sb = smem + par * T_BUF; float* acP = acS + par * 64;
            const bf16* StR = StS + par * (T_STSZ / 2); bf16* StW = StS + (par ^ 1) * (T_STSZ / 2);
            const float dec = __expf(R.alast);
            { const float e2 = __expf(R.alast - R.acl);
#pragma unroll
              for (int i = 0; i < 2; ++i) { const int q = tid + 512 * i, l = q >> 4, c8 = q & 15; *(v4u*)(sb + T_CS + l * 272 + c8 * 16) = R.Cr[i]; *(v4u*)(sb + T_BS + l * 272 + c8 * 16) = R.Br[i]; }
              const int l = tid >> 3, p4 = (tid & 7) * 4;
              const float x0 = bflo(R.Xr.x) * R.dtl, x1 = bfhi(R.Xr.x) * R.dtl, x2 = bflo(R.Xr.y) * R.dtl, x3 = bfhi(R.Xr.y) * R.dtl;
              v2u d; d.x = cvt_pk_bf16(x0, x1); d.y = cvt_pk_bf16(x2, x3); *(v2u*)(sb + T_XD + l * 80 + p4 * 2) = d;
              v2u e; e.x = cvt_pk_bf16(x0 * e2, x1 * e2); e.y = cvt_pk_bf16(x2 * e2, x3 * e2); *(v2u*)(sb + T_XE + l * 80 + p4 * 2) = e;
              *(v2u*)(sb + T_XS + l * 64 + p4 * 2) = R.Xr; *(v2u*)(sb + T_ZS + l * 64 + p4 * 2) = R.Zr;
              if (w == 0) acP[lane] = R.aclane; }
            BAR_LDS();
            if (ci + 2 < nchunks) load_chunk(ci + 2, R);
            bf16x8 cf[4];
#pragma unroll
            for (int k = 0; k < 4; ++k) cf[k] = *(const bf16x8*)(sb + T_CS + (lt * 16 + fr) * 272 + (k * 32 + fq * 8) * 2);
            f32x4 yo = {0.f, 0.f, 0.f, 0.f};
#pragma unroll
            for (int k = 0; k < 4; ++k) { const bf16x8 bb = *(const bf16x8*)((const unsigned char*)StR + (pt * 16 + fr) * 272 + (k * 32 + fq * 8) * 2); yo = mfma16(cf[k], bb, yo); }
{ const f32x4 a4 = *(const f32x4*)(acP + lt * 16 + fq * 4);
#pragma unroll
              for (int j = 0; j < 4; ++j) yo[j] *= __expf(a4[j]); }
            const float acl_fr = acP[lt * 16 + fr]; const int lrow = lt * 16 + fr;
#pragma unroll
            for (int t = 0; t < 2; ++t) {
                if (2 * t <= lt) {
                    v2u xb0, xb1;
                    { const unsigned a0 = lds0 + par * T_BUF + T_XD + (32 * t + 4 * fq + tq) * 80 + (pt * 16 + 4 * tp) * 2, a1 = a0 + 16 * 80; TR_ISSUE(xb0, a0); TR_ISSUE(xb1, a1); }
                    float m[8];
                    { f32x4 s0 = {0.f, 0.f, 0.f, 0.f}, s1 = {0.f, 0.f, 0.f, 0.f};
#pragma unroll
                      for (int k = 0; k < 4; ++k) { const bf16x8 bf0 = *(const bf16x8*)(sb + T_BS + ((2 * t) * 16 + fr) * 272 + (k * 32 + fq * 8) * 2), bf1 = *(const bf16x8*)(sb + T_BS + ((2 * t + 1) * 16 + fr) * 272 + (k * 32 + fq * 8) * 2);
                          s0 = mfma16(bf0, cf[k], s0); s1 = mfma16(bf1, cf[k], s1); }
                      const f32x4 a0 = *(const f32x4*)(acP + (2 * t) * 16 + fq * 4), a1 = *(const f32x4*)(acP + (2 * t + 1) * 16 + fq * 4);
#pragma unroll
                      for (int j = 0; j < 4; ++j) { const int si0 = (2 * t) * 16 + fq * 4 + j, si1 = si0 + 16;
                          const float e0 = s0[j] * __expf(fminf(acl_fr - a0[j], 0.f)), e1 = s1[j] * __expf(fminf(acl_fr - a1[j], 0.f));
                          m[j] = (si0 <= lrow) ? e0 : 0.f; m[4 + j] = (si1 <= lrow) ? e1 : 0.f; } }
                    v4u mp; mp.x = cvt_pk_bf16(m[0], m[1]); mp.y = cvt_pk_bf16(m[2], m[3]); mp.z = cvt_pk_bf16(m[4], m[5]); mp.w = cvt_pk_bf16(m[6], m[7]);
                    asm volatile("s_waitcnt lgkmcnt(0)" : "+v"(xb0), "+v"(xb1) :: "memory");
                    yo = mfma16(__builtin_bit_cast(bf16x8, mp), mk8(xb0, xb1), yo);
                }
            }
#pragma unroll
            for (int j = 0; j < 4; ++j) { const int l = lt * 16 + fq * 4 + j, p = pt * 16 + fr; const float xv = bf2f(*(const bf16*)(sb + T_XS + l * 64 + p * 2)), zv = bf2f(*(const bf16*)(sb + T_ZS + l * 64 + p * 2));
                ypre[(size_t)(row0 + l) * DINNER + h * 64 + ph * 32 + p] = f2bfh((yo[j] + Dh * xv) * siluf_(zv)); }
            { v2u xa[2][2][2], bb[2][2];
#pragma unroll
              for (int kk = 0; kk < 2; ++kk) {
#pragma unroll
                  for (int hh = 0; hh < 2; ++hh) { const int r = kk * 32 + 8 * fq + 4 * hh + tq;
                      TR_ISSUE(bb[kk][hh], lds0 + par * T_BUF + T_BS + r * 272 + (w * 16 + 4 * tp) * 2);
#pragma unroll
                      for (int p2 = 0; p2 < 2; ++p2) TR_ISSUE(xa[p2][kk][hh], lds0 + par * T_BUF + T_XE + r * 80 + (p2 * 16 + 4 * tp) * 2); } }
              asm volatile("s_waitcnt lgkmcnt(0)" : "+v"(xa[0][0][0]), "+v"(xa[0][0][1]), "+v"(xa[0][1][0]), "+v"(xa[0][1][1]), "+v"(xa[1][0][0]), "+v"(xa[1][0][1]), "+v"(xa[1][1][0]), "+v"(xa[1][1][1]),
                           "+v"(bb[0][0]), "+v"(bb[0][1]), "+v"(bb[1][0]), "+v"(bb[1][1]) :: "memory");
#pragma unroll
              for (int p2 = 0; p2 < 2; ++p2) { st[p2] *= dec;
#pragma unroll
                  for (int kk = 0; kk < 2; ++kk) st[p2] = mfma16(mk8(xa[p2][kk][0], xa[p2][kk][1]), mk8(bb[kk][0], bb[kk][1]), st[p2]); } }
#pragma unroll
            for (int p2 = 0; p2 < 2; ++p2)
#pragma unroll
                for (int j = 0; j < 4; ++j) StW[(p2 * 16 + fq * 4 + j) * 136 + w * 16 + fr] = (bf16)f2bf(st[p2][j]);
        };
        for (int ci = 0; ci < nchunks; ci += 2) { step(ci, RA, 0); if (ci + 1 < nchunks) step(ci + 1, RB, 1); }
        if (seg + 1 < NSEG) {
#pragma unroll
            for (int p2 = 0; p2 < 2; ++p2)
#pragma unroll
                for (int j = 0; j < 4; ++j) stw[(size_t)(p2 * 16 + fq * 4 + j) * 128 + w * 16 + fr] = st[p2][j]; }
        __syncthreads();
    }
    __builtin_amdgcn_s_setprio(0);
}

__device__ __forceinline__ void phase_gnorm(const Params& P, int seg) {
    GAS bf16* ypre = (GAS bf16*)(launder_s(P.ws) + WS_YPRE);
    const int tidl = launder_v(threadIdx.x); const int lane = tidl & 63, gw = blockIdx.x * 8 + (tidl >> 6), NGW = grid_x() * 8;
    const int nrows = (seg == 0) ? RS + 16 : RS;
    for (int rr = gw; rr < nrows; rr += NGW) { const int row = (rr < RS) ? rr : rr + 48; GAS bf16* p = ypre + (size_t)row * DINNER + lane * 8;
        v4u raw[8];
#pragma unroll
        for (int g = 0; g < 8; ++g) raw[g] = *(const GAS v4u*)(p + g * 512);
#pragma unroll
        for (int g = 0; g < 8; ++g) { float f[8]; unpack8(raw[g], f); float s = 0.f;
#pragma unroll
            for (int e = 0; e < 8; ++e) s += f[e] * f[e];
            s = wave_sum(s); const float rs = rsqrtf(s * (1.f / 512.f) + EPS);
#pragma unroll
            for (int e = 0; e < 8; ++e) f[e] *= rs;
            *(GAS v4u*)(p + g * 512) = pack8(f); } }
}

__device__ __forceinline__ void phase_ffnfix(const Params& P, int seg) {
    gws_t ws = launder_s(P.ws);
    GAS bf16* act = (GAS bf16*)(ws + WS_ACT);
    const GAS float* eu = (const GAS float*)(ws + WS_EU) + (size_t)(seg & 1) * (32 * 4 * DFF); const GAS float* eup = (const GAS float*)(ws + WS_EU) + (size_t)((seg + 1) & 1) * (32 * 4 * DFF);
    const GAS float* ev = (const GAS float*)(ws + WS_EV); const GAS float* um = (const GAS float*)(ws + WS_UMETA);
    const int gtid = blockIdx.x * NTHREADS + launder_v(threadIdx.x), NT = grid_x() * NTHREADS;
    for (int idx = gtid; idx < 32 * DFF; idx += NT) { const int pm = idx / DFF, c = idx % DFF;
        const GAS float* hp;
        if (pm & 15) hp = eu + (size_t)(pm - 1) * 4 * DFF; else if (seg > 0) hp = eup + (size_t)(pm + 15) * 4 * DFF; else hp = nullptr;
        const float h0 = hp ? hp[c] : um[c], h1 = hp ? hp[DFF + c] : um[DFF + c];
        const float u0 = eu[((size_t)pm * 4 + 2) * DFF + c], u1 = eu[((size_t)pm * 4 + 3) * DFF + c], v0 = ev[((size_t)pm * 2 + 0) * DFF + c], v1 = ev[((size_t)pm * 2 + 1) * DFF + c];
        const float w0 = P.ffn_conv_w[c], w1 = P.ffn_conv_w[DFF + c], w2 = P.ffn_conv_w[2 * DFF + c], bb = P.ffn_conv_b[c];
        act[(size_t)(pm * 256) * DFF + c] = (bf16)f2bf(siluf_(bb + w0 * h0 + w1 * h1 + w2 * u0) * v0);
        act[(size_t)(pm * 256 + 1) * DFF + c] = (bf16)f2bf(siluf_(bb + w0 * h1 + w1 * u0 + w2 * u1) * v1); }
}

__device__ __forceinline__ void phase_final(const Params& P, int sg, int blk0) {
    const GAS float* ssq3 = (const GAS float*)(launder_s(P.ws) + WS_SSQ3);
    const int tidl = launder_v(threadIdx.x); const int lane = tidl & 63, gw = ((int)blockIdx.x - blk0) * 8 + (tidl >> 6), NGW = (grid_x() - blk0) * 8;
    if (gw < 0) return;
    f32x4 gf[4][2];
#pragma unroll
    for (int i = 0; i < 4; ++i) { gf[i][0] = ((const f32x4*)P.normf_g)[2 * (lane + 64 * i)]; gf[i][1] = ((const f32x4*)P.normf_g)[2 * (lane + 64 * i) + 1]; }
    for (int lr = gw; lr < RS; lr += NGW) { const int rid = (lr / TSEG) * SEQ + sg * TSEG + (lr % TSEG);
        float s = (lane < 32) ? ssq3[((size_t)sg * RS + lr) * 32 + lane] : 0.f; s = wave_sum(s);
        const float rs = rsqrtf(s * (1.f / DM) + EPS);
        GAS float* orow = (GAS float*)P.out + (size_t)rid * DM;
        v4u hb[4];
#pragma unroll
        for (int i = 0; i < 4; ++i) hb[i] = __builtin_nontemporal_load((const GAS v4u*)orow + lane + 64 * i);
        __builtin_amdgcn_s_waitcnt(0x0070);
#pragma unroll
        for (int i = 0; i < 4; ++i) { float f[8]; unpack8(hb[i], f); const int c = lane + 64 * i;
            const f32x4 a = (f32x4){f[0], f[1], f[2], f[3]} * rs * gf[i][0], d = (f32x4){f[4], f[5], f[6], f[7]} * rs * gf[i][1];
            __builtin_nontemporal_store(a, (GAS f32x4*)orow + 2 * c); __builtin_nontemporal_store(d, (GAS f32x4*)orow + 2 * c + 1); } }
}


template <class F> __device__ __forceinline__ void skinny_tile(const GAS bf16* A, int lda, const GAS bf16* Bt, int K, int n0, int lane, F&& epi) {
    const int fr = lane & 15, fq = lane >> 4;
    const GAS bf16* ap = A + (size_t)fr * lda + fq * 8; const GAS bf16* bp = Bt + (size_t)(n0 + fr) * K + fq * 8;
    f32x4 acc0 = {0.f, 0.f, 0.f, 0.f}, acc1 = {0.f, 0.f, 0.f, 0.f};
    bf16x8 a[4], bb[4], a2[4], b2[4];
#pragma unroll
    for (int i = 0; i < 4; ++i) { a[i] = *(const GAS bf16x8*)(ap + i * 32); bb[i] = *(const GAS bf16x8*)(bp + i * 32); }
    for (int k = 0; k < K; k += 256) {
#pragma unroll
        for (int i = 0; i < 4; ++i) { a2[i] = *(const GAS bf16x8*)(ap + k + 128 + i * 32); b2[i] = *(const GAS bf16x8*)(bp + k + 128 + i * 32); }
#pragma unroll
        for (int i = 0; i < 4; i += 2) { acc0 = mfma16(a[i], bb[i], acc0); acc1 = mfma16(a[i + 1], bb[i + 1], acc1); }
        if (k + 256 < K) {
#pragma unroll
            for (int i = 0; i < 4; ++i) { a[i] = *(const GAS bf16x8*)(ap + k + 256 + i * 32); bb[i] = *(const GAS bf16x8*)(bp + k + 256 + i * 32); } }
#pragma unroll
        for (int i = 0; i < 4; i += 2) { acc0 = mfma16(a2[i], b2[i], acc0); acc1 = mfma16(a2[i + 1], b2[i + 1], acc1); } }
#pragma unroll
    for (int j = 0; j < 4; ++j) epi(fq * 4 + j, j, n0 + fr, acc0[j] + acc1[j]);
}
template <class F> __device__ __forceinline__ void skinny_tile_sk(const GAS bf16* A, int lda, const GAS bf16* Bt, int K, int n0, int wave, int lane, float* red, F&& epi) {
    const int fr = lane & 15, fq = lane >> 4, kc = K >> 3;
    const GAS bf16* ap = A + (size_t)fr * lda + wave * kc + fq * 8; const GAS bf16* bp = Bt + (size_t)(n0 + fr) * K + wave * kc + fq * 8;
    f32x4 acc0 = {0.f, 0.f, 0.f, 0.f}, acc1 = {0.f, 0.f, 0.f, 0.f};
    for (int k = 0; k < kc; k += 256) { bf16x8 a[8], bb[8];
#pragma unroll
        for (int i = 0; i < 8; ++i) { a[i] = *(const GAS bf16x8*)(ap + k + i * 32); bb[i] = *(const GAS bf16x8*)(bp + k + i * 32); }
#pragma unroll
        for (int i = 0; i < 8; i += 2) { acc0 = mfma16(a[i], bb[i], acc0); acc1 = mfma16(a[i + 1], bb[i + 1], acc1); } }
    __syncthreads();
    *(f32x4*)(red + wave * 256 + lane * 4) = acc0 + acc1;
    __syncthreads();
    if (wave == 0) { f32x4 s = {0.f, 0.f, 0.f, 0.f};
#pragma unroll
        for (int w = 0; w < 8; ++w) s += *(const f32x4*)(red + w * 256 + lane * 4);
#pragma unroll
        for (int j = 0; j < 4; ++j) epi(fq * 4 + j, j, n0 + fr, s[j]); }
}
__device__ __forceinline__ void side_gemm1(const Params& P, int seg) {
    gws_t ws = launder_s(P.ws);
    const int tidl = launder_v(threadIdx.x), lane = tidl & 63, gw = blockIdx.x * 8 + (tidl >> 6), NGW = grid_x() * 8;
    const GAS bf16* xb = (const GAS bf16*)(ws + WS_XB) + (size_t)seg * RSB * DM; const GAS float* rstd1 = (const GAS float*)(ws + WS_RSTD1) + (size_t)seg * RSB;
    const GAS bf16* Wt = (const GAS bf16*)(ws + WS_WIN); GAS float* dtv = (GAS float*)(ws + WS_DT); GAS bf16* proj = (GAS bf16*)(ws + WS_PROJ);
    const int nrt = RS / 16 + (seg == 0 ? 1 : 0);
    for (int it = gw; it < nrt * 4; it += NGW) { const int rt = it >> 2, r0 = (rt < RS / 16) ? rt * 16 : RS + 48;
        skinny_tile(xb + (size_t)r0 * DM, DM, Wt + (size_t)NPROJ * DM, DM, (it & 3) * 16, lane, [&](int row, int j, int col, float v) {
            const float t = v * rstd1[r0 + row] + P.dt_bias[col]; dtv[(size_t)(r0 + row) * 64 + col] = (t > 20.f) ? t : log1pf(__expf(t)); }); }
    if (seg == 0) {
        for (int it = gw; it < NPROJ / 16; it += NGW)
            skinny_tile(xb + (size_t)(RS + 48) * DM, DM, Wt, DM, it * 16, lane, [&](int row, int j, int col, float v) { proj[(size_t)(RS + 48 + row) * NPROJ + col] = (bf16)f2bf(v * rstd1[RS + 48 + row]); });
        const int gtid = blockIdx.x * NTHREADS + tidl, NT = grid_x() * NTHREADS;
        for (int idx = gtid; idx < 3 * (NPROJ / 8); idx += NT) { v4u z; z.x = 0u; z.y = 0u; z.z = 0u; z.w = 0u; *(GAS v4u*)(proj + (size_t)(RS + 45 + idx / (NPROJ / 8)) * NPROJ + (idx % (NPROJ / 8)) * 8) = z; }
        for (int idx = gtid; idx < 48 * 64; idx += NT) dtv[(size_t)RS * 64 + idx] = 0.f;
    }
}
__device__ __forceinline__ void side_gemm2(const Params& P, unsigned char* smem) {
    gws_t ws = launder_s(P.ws);
    const int tidl = launder_v(threadIdx.x), lane = tidl & 63, gw = blockIdx.x * 8 + (tidl >> 6), NGW = grid_x() * 8;
    const GAS bf16* proj = (const GAS bf16*)(ws + WS_PROJ); GAS bf16* ta = (GAS bf16*)(ws + WS_TA);
    for (int it = blockIdx.x; it < DM / 16; it += NGW / 8)
        skinny_tile_sk((const GAS bf16*)(ws + WS_YA) + (size_t)(RS + 48) * DM, DM, (const GAS bf16*)(ws + WS_WA), DM, it * 16, tidl >> 6, lane, (float*)smem, [&](int row, int j, int col, float v) {
            const int r = RS + 48 + row; ta[(size_t)r * DM + col] = (bf16)f2bf(sigmoidf_(bf2f(proj[(size_t)r * NPROJ + OFF_GATE + col]) + P.b_gate[col]) * v); });
}
__device__ __forceinline__ void side_gemm3(const Params& P, unsigned char* smem) {
    gws_t ws = launder_s(P.ws);
    const int tidl = launder_v(threadIdx.x), lane = tidl & 63, gw = blockIdx.x * 8 + (tidl >> 6), NGW = grid_x() * 8;
    const GAS bf16* proj = (const GAS bf16*)(ws + WS_PROJ); const GAS bf16* ta = (const GAS bf16*)(ws + WS_TA); GAS bf16* mix = (GAS bf16*)(ws + WS_MIX);
    for (int it = blockIdx.x; it < DM / 16; it += NGW / 8)
        skinny_tile_sk((const GAS bf16*)(ws + WS_YPRE) + (size_t)(RS + 48) * DINNER, DINNER, (const GAS bf16*)(ws + WS_WM), DINNER, it * 16, tidl >> 6, lane, (float*)smem, [&](int row, int j, int col, float v) {
            const int r = RS + 48 + row; mix[(size_t)r * DM + col] = (bf16)f2bf(bf2f(ta[(size_t)r * DM + col]) + sigmoidf_(bf2f(proj[(size_t)r * NPROJ + OFF_GATE + DM + col]) + P.b_gate[DM + col]) * v); });
}
__device__ __forceinline__ void side_gemm4(const Params& P, unsigned char* smem) {
    gws_t ws = launder_s(P.ws);
    const int tidl = launder_v(threadIdx.x), lane = tidl & 63, gw = blockIdx.x * 8 + (tidl >> 6), NGW = grid_x() * 8;
    GAS bf16* h1b = (GAS bf16*)(ws + WS_H1B); GAS float* ssqm = (GAS float*)(ws + WS_SSQM);
    for (int it = blockIdx.x; it < DM / 16; it += NGW / 8) { float sq0 = 0.f, sq1 = 0.f, sq2 = 0.f, sq3 = 0.f;
        skinny_tile_sk((const GAS bf16*)(ws + WS_MIX) + (size_t)(RS + 48) * DM, DM, (const GAS bf16*)(ws + WS_WO), DM, it * 16, tidl >> 6, lane, (float*)smem, [&](int row, int j, int col, float v) {
            const float hv = P.meta[(size_t)row * DM + col] + v; h1b[(size_t)(RS + 48 + row) * DM + col] = (bf16)f2bf(hv);
            const float q = hv * hv; if (j == 0) sq0 = q; else if (j == 1) sq1 = q; else if (j == 2) sq2 = q; else sq3 = q; });
        float sq[4] = {sq0, sq1, sq2, sq3};
        if ((tidl >> 6) == 0)
#pragma unroll
        for (int j = 0; j < 4; ++j) { float s = sq[j]; s += __shfl_xor(s, 1); s += __shfl_xor(s, 2); s += __shfl_xor(s, 4); s += __shfl_xor(s, 8);
            if ((lane & 15) == 0) ssqm[((lane >> 4) * 4 + j) * 128 + it] = s; } }
}
__device__ __forceinline__ void side_gemm5(const Params& P, unsigned char* smem) {
    gws_t ws = launder_s(P.ws);
    const int tidl = launder_v(threadIdx.x), lane = tidl & 63, gw = blockIdx.x * 8 + (tidl >> 6), NGW = grid_x() * 8;
    const GAS float* ssqm = (const GAS float*)(ws + WS_SSQM); GAS float* um = (GAS float*)(ws + WS_UMETA);
    for (int it = blockIdx.x; it < DFF / 16; it += NGW / 8) {
        float s = 0.f;
        for (int i = 0; i < 32; ++i) s += ssqm[(lane & 15) * 128 + (lane >> 4) * 32 + i];
        s += __shfl_xor(s, 16); s += __shfl_xor(s, 32);
        const float rsl = rsqrtf(s * (1.f / DM) + EPS);
        const float r2 = __shfl(rsl, 14), r3 = __shfl(rsl, 15);
        const int n0 = 256 * (it >> 3) + 16 * (it & 7);
        skinny_tile_sk((const GAS bf16*)(ws + WS_H1B) + (size_t)(RS + 48) * DM, DM, (const GAS bf16*)(ws + WS_WUP), DM, n0, tidl >> 6, lane, (float*)smem, [&](int row, int j, int col, float v) {
            if (row >= 14) um[(size_t)(row - 14) * DFF + 16 * it + (col - n0)] = v * ((row == 14) ? r2 : r3); }); }
}

#define XB_TMO      128
#define XB_XCNT(j)  (256  + 64 * (j))
#define XB_XSUB(j)  (1280 + 64 * (j))
#define XB_XGEN(j)  (2304 + 64 * (j))
#define XB_TOP      3328
#define XB_TOPGEN   3392
#define XCD_BAR_WORDS 3456
#define XB_SPIN_CAP (1u << 18)

__device__ __forceinline__ unsigned xb_ld(unsigned* p)              { return __hip_atomic_load(p, __ATOMIC_RELAXED, __HIP_MEMORY_SCOPE_AGENT); }
__device__ __forceinline__ unsigned xb_add(unsigned* p, unsigned v) { return __hip_atomic_fetch_add(p, v, __ATOMIC_RELAXED, __HIP_MEMORY_SCOPE_AGENT); }
__device__ __forceinline__ unsigned xb_xcc_id() { return (unsigned)__builtin_amdgcn_s_getreg((3 << 11) | 20) & 0xFu; }
#define XB_SPIN(cond, bar) do { unsigned _sp = 0; while (cond) { __builtin_amdgcn_s_sleep(1); \
    if ((++_sp & 255u) == 0u) { if (xb_ld(&(bar)[XB_TMO])) break; if (_sp > XB_SPIN_CAP) { atomicAdd(&(bar)[XB_TMO], 1u); break; } } } } while (0)

struct XcdBarrier {
    unsigned* bar; unsigned x;
    volatile LAS unsigned* st;
};

__device__ __forceinline__ XcdBarrier xcd_barrier_post(unsigned* bar, volatile LAS unsigned* st) {
    XcdBarrier b; b.bar = bar; b.x = xb_xcc_id(); b.st = st;
    if (threadIdx.x == 0) (void)xb_add(&bar[XB_XCNT(b.x)], 1u);
    return b;
}
__device__ __forceinline__ void xcd_barrier_complete(unsigned* bar, unsigned x, unsigned& nloc, unsigned& nx) {
    const unsigned G = gridDim.x * gridDim.y * gridDim.z;
    unsigned sum, cnt, mine, sp = 0u;
    for (;;) {
        sum = 0u; cnt = 0u; mine = 0u;
#pragma unroll
        for (unsigned j = 0; j < 16; ++j) { const unsigned c = xb_ld(&bar[XB_XCNT(j)]); sum += c; cnt += (c > 0u) ? 1u : 0u; mine = (j == x) ? c : mine; }
        if (sum == G) break;
        __builtin_amdgcn_s_sleep(1);
        if ((++sp & 255u) == 0u) { if (xb_ld(&bar[XB_TMO])) break; if (sp > XB_SPIN_CAP) { atomicAdd(&bar[XB_TMO], 1u); break; } }
    }
    nloc = mine > 0u ? mine : 1u; nx = cnt > 0u ? cnt : 1u;
}

__device__ __forceinline__ void xcd_barrier(const XcdBarrier& b) {
    asm volatile("s_waitcnt vmcnt(0)" ::: "memory");
    __syncthreads();
    if (threadIdx.x == 0) {
        unsigned* bar = b.bar;
        __builtin_amdgcn_s_waitcnt(0);
        unsigned nloc = b.st[0], nx = b.st[1];
        if (nloc == 0u) { xcd_barrier_complete(bar, b.x, nloc, nx); b.st[0] = nloc; b.st[1] = nx; }
        const unsigned old = xb_add(&bar[XB_XSUB(b.x)], 1u);
        const unsigned gen = old / nloc;
        if (old + 1u == (gen + 1u) * nloc) {
            __builtin_amdgcn_fence(__ATOMIC_RELEASE, "agent");
            asm volatile("s_waitcnt vmcnt(0)" ::: "memory");
            const unsigned og = xb_add(&bar[XB_TOP], 1u);
            const unsigned tg = og / nx;
            if (og + 1u == (tg + 1u) * nx) xb_add(&bar[XB_TOPGEN], 1u);
            else XB_SPIN(xb_ld(&bar[XB_TOPGEN]) == tg, bar);
            __builtin_amdgcn_fence(__ATOMIC_ACQUIRE, "agent");
            xb_add(&bar[XB_XGEN(b.x)], 1u);
            asm volatile("s_waitcnt vmcnt(0)" ::: "memory");
        } else {
            XB_SPIN(xb_ld(&bar[XB_XGEN(b.x)]) == gen, bar);
            __builtin_amdgcn_fence(__ATOMIC_ACQUIRE, "agent");
            asm volatile("s_waitcnt vmcnt(0)" ::: "memory");
        }
    }
    __syncthreads();
}

#ifndef REP_G1
#define REP_G1 1
#endif
#ifndef REP_SIDE
#define REP_SIDE 1
#endif
#ifndef REP_GX
#define REP_GX 1
#endif
#ifndef REP_P0
#define REP_P0 1
#endif
#ifndef REP_SSD
#define REP_SSD 1
#endif
#ifndef REP_ELT
#define REP_ELT 1
#endif
__global__ void __launch_bounds__(NTHREADS, 2) hybrid_fwd(Params P) {
    extern __shared__ __attribute__((aligned(16))) unsigned char smem[];
    cg::grid_group grid = cg::this_grid();
    gws_t ws = (gws_t)P.ws;
    volatile LAS unsigned* xst = (volatile LAS unsigned*)(smem + LDS_STAGE);
    if (threadIdx.x < 2) xst[threadIdx.x] = 0u;
    __syncthreads();
    if (blockIdx.x == 0) { GAS unsigned* bw = (GAS unsigned*)(ws + WS_BAR);
        for (int i = threadIdx.x; i < XCD_BAR_WORDS; i += NTHREADS) bw[i] = 0u;
        __threadfence(); }
    for (int rep = 0; rep < REP_P0; ++rep) phase_prep(P, smem);
    grid.sync();
    XcdBarrier xb = xcd_barrier_post((unsigned*)(GAS unsigned*)(ws + WS_BAR), xst);
    for (int seg = 0; seg < NSEG; ++seg) {
        ws = launder_s((const void*)ws);
        { Epi1 E; E.O = (GAS bf16*)(ws + WS_PROJ); E.rstd = (const GAS float*)(ws + WS_RSTD1) + (size_t)seg * RSB;
          for (int rep = 0; rep < REP_G1; ++rep) run_gemm(smem, (const GAS bf16*)(ws + WS_XB) + (size_t)seg * RSB * DM, (const GAS bf16*)(ws + WS_WIN), RS, NPROJ, DM, E); }
        for (int rep = 0; rep < REP_SIDE; ++rep) side_gemm1(P, seg);
        xcd_barrier(xb);
        for (int rep = 0; rep < REP_ELT; ++rep) phase_conv(P, seg);
        xcd_barrier(xb);
        for (int rep = 0; rep < REP_SSD; ++rep) phase_ssd(P, seg, smem);
        xcd_barrier(xb);
        phase_gnorm(P, seg);
        ws = launder_s((const void*)ws);
        { EpiGate<0> E; E.proj = (const GAS bf16*)(ws + WS_PROJ); E.bgate = P.b_gate; E.ta = (GAS bf16*)(ws + WS_TA); E.mix = (GAS bf16*)(ws + WS_MIX);
          for (int rep = 0; rep < REP_GX; ++rep) run_gemm(smem, (const GAS bf16*)(ws + WS_YA), (const GAS bf16*)(ws + WS_WA), RS, DM, DM, E); }
        if (seg == 0) side_gemm2(P, smem);
        xcd_barrier(xb);
        ws = launder_s((const void*)ws);
        { EpiGate<1> E; E.proj = (const GAS bf16*)(ws + WS_PROJ); E.bgate = P.b_gate; E.ta = (GAS bf16*)(ws + WS_TA); E.mix = (GAS bf16*)(ws + WS_MIX);
          for (int rep = 0; rep < REP_GX; ++rep) run_gemm(smem, (const GAS bf16*)(ws + WS_YPRE), (const GAS bf16*)(ws + WS_WM), RS, DM, DINNER, E); }
        if (seg == 0) side_gemm3(P, smem);
        xcd_barrier(xb);
        ws = launder_s((const void*)ws);
        { Epi4 E; E.x = P.x; E.meta = P.meta; E.h1b = (GAS bf16*)(ws + WS_H1B); E.ssq = (GAS float*)(ws + WS_SSQ2); E.seg = seg;
          for (int rep = 0; rep < REP_GX; ++rep) run_gemm(smem, (const GAS bf16*)(ws + WS_MIX), (const GAS bf16*)(ws + WS_WO), RS, DM, DM, E); }
        if (seg == 0) side_gemm4(P, smem);
        xcd_barrier(xb);
        ws = launder_s((const void*)ws);
        { Epi5 E; E.act = (GAS bf16*)(ws + WS_ACT); E.ssq = (const GAS float*)(ws + WS_SSQ2); E.cw = P.ffn_conv_w; E.cb = P.ffn_conv_b; E.xch = (LAS float*)(smem + LDS_XCH);
          E.eu = (GAS float*)(ws + WS_EU) + (size_t)(seg & 1) * (32 * 4 * DFF); E.ev = (GAS float*)(ws + WS_EV);
          for (int rep = 0; rep < REP_GX; ++rep) run_gemm(smem, (const GAS bf16*)(ws + WS_H1B), (const GAS bf16*)(ws + WS_WUP), RS, NUP, DM, E); }
        if (seg == 0) side_gemm5(P, smem);
        if (seg > 0) phase_final(P, seg - 1, (RS / 256) * (NUP / 256) - 5 * 256);
        xcd_barrier(xb);
        phase_ffnfix(P, seg);
        xcd_barrier(xb);
        ws = launder_s((const void*)ws);
        { Epi6 E; E.h1 = (const GAS bf16*)(ws + WS_H1B); E.out = P.out; E.ssq = (GAS float*)(ws + WS_SSQ3); E.seg = seg;
          for (int rep = 0; rep < REP_GX; ++rep) run_gemm(smem, (const GAS bf16*)(ws + WS_ACT), (const GAS bf16*)(ws + WS_WDN), RS, DM, DFF, E); }
        if (seg + 1 == NSEG) xcd_barrier(xb);
    }
    phase_final(P, NSEG - 1, 0);
}

extern "C" void kernel_launch(void* const* d_in, const int* in_sizes, int n_in, void* d_out, int out_size, void* d_ws, size_t ws_size, hipStream_t stream) {
    static int grid_blocks = 0;
    if (grid_blocks == 0) {
        if (n_in != 21 || in_sizes[0] != NBATCH * SEQ * DM || out_size != NBATCH * SEQ * DM || ws_size < WS_END) {
            fprintf(stderr, "kernel_launch: unexpected shapes (n_in %d, in0 %d, out %d, ws %zu, need %zu)\n", n_in, n_in > 0 ? in_sizes[0] : -1, out_size, ws_size, (size_t)WS_END); grid_blocks = -1; return; }
        int dev = 0, cus = 0, per_cu = 0;
        hipGetDevice(&dev); hipDeviceGetAttribute(&cus, hipDeviceAttributeMultiprocessorCount, dev);
        if (hipFuncSetAttribute((const void*)hybrid_fwd, hipFuncAttributeMaxDynamicSharedMemorySize, LDS_BYTES) != hipSuccess) { fprintf(stderr, "kernel_launch: hipFuncSetAttribute failed\n"); grid_blocks = -1; return; }
        hipOccupancyMaxActiveBlocksPerMultiprocessor(&per_cu, (const void*)hybrid_fwd, NTHREADS, LDS_BYTES);
        if (per_cu < 1) { fprintf(stderr, "kernel_launch: occupancy query says %d blocks per CU\n", per_cu); per_cu = 1; }
        (void)hipGetLastError();
        grid_blocks = cus * per_cu;
    }
    if (grid_blocks < 0) return;
    Params p{};
    const float** pp = (const float**)&p;
    for (int i = 0; i < 21; ++i) pp[i] = (const float*)d_in[i];
    p.out = (float*)d_out; p.ws = (unsigned char*)d_ws;
    void* args[] = {&p};
    hipError_t e = hipLaunchCooperativeKernel((const void*)hybrid_fwd, dim3(grid_blocks), dim3(NTHREADS), args, LDS_BYTES, stream);
    if (e != hipSuccess) fprintf(stderr, "cooperative launch failed: %s (grid %d)\n", hipGetErrorString(e), grid_blocks);
}
```
